# Optimizing an MI355X kernel written in HIP

```python
import jax, jax.numpy as jnp
from jax import lax
import numpy as np

D_MODEL = 2048
BATCH = 8
SEQ = 2048
DEPTH = 1

CHUNK = 64
N_META = 16
D_MIX = D_MODEL
D_CONV = D_MIX // 2
CONV_GROUPS = 8
CONV_K = 3
D_ATTN = D_MIX - D_CONV
N_ATTN_HEADS = 8
ATTN_HEAD_DIM = D_ATTN // N_ATTN_HEADS
HEAD_DIM_OUT = D_CONV // CONV_GROUPS
Q_BLOCK = 128
D_IN_PROJ = 3 * D_CONV + 3 * D_ATTN
N_PEER_HEADS = 8
PEER_TOPK = 16
N_KEYS = 128
N_EXPERTS = N_KEYS * N_KEYS
D_QUERY = 256
D_SUBKEY = D_QUERY // 2
PEER_TOKEN_BLOCK = 128
EPS = 1e-6

kernel_name = "hybrid_conv_stickbreak_peer"


def rmsnorm(x, g):
    xf = x.astype(jnp.float32)
    y = xf * lax.rsqrt(jnp.mean(xf * xf, axis=-1, keepdims=True) + EPS)
    return (y * g.astype(jnp.float32)).astype(x.dtype)


def short_gated_conv(gate_b, gate_c, conv_in, conv_w):
    t = conv_in.shape[1]
    u = gate_c * conv_in
    up = jnp.pad(u, ((0, 0), (CONV_K - 1, 0), (0, 0)))
    y = up[:, 0:t] * conv_w[0]
    for j in range(1, CONV_K):
        y = y + up[:, j:j + t] * conv_w[j]
    return gate_b * y


def stick_breaking_attention(q, k, v):
    b, nh, t, dh = q.shape
    t_pad = -(-t // Q_BLOCK) * Q_BLOCK
    pad = ((0, 0), (0, 0), (0, t_pad - t), (0, 0))
    q, k, v = jnp.pad(q, pad), jnp.pad(k, pad), jnp.pad(v, pad)
    scale = dh ** -0.5
    outs = []
    for blk in range(t_pad // Q_BLOCK):
        q_lo = blk * Q_BLOCK
        kv_len = q_lo + Q_BLOCK
        qb = q[:, :, q_lo:kv_len]
        kb = k[:, :, :kv_len]
        vb = v[:, :, :kv_len]
        z = jnp.einsum('bhqd,bhkd->bhqk', qb, kb).astype(jnp.float32) * scale
        q_pos = q_lo + jnp.arange(Q_BLOCK)[:, None]
        k_pos = jnp.arange(kv_len)[None, :]
        past = k_pos < q_pos
        log_not = jnp.where(past, jax.nn.log_sigmoid(-z), 0.0)
        rest = lax.cumsum(log_not, axis=3, reverse=True) - log_not
        w = jnp.where(past, jnp.exp(jax.nn.log_sigmoid(z) + rest), 0.0)
        outs.append(jnp.einsum('bhqk,bhkd->bhqd', w.astype(vb.dtype), vb))
    return jnp.concatenate(outs, axis=2)[:, :, :t]


def mixer_sublayer(h, norm_g, w_in, conv_w, q_norm_g, k_norm_g, out_norm_g, w_out):
    b, t, _ = h.shape
    xn = rmsnorm(h, norm_g)
    proj = xn @ w_in
    gate_b, gate_c, conv_in, q, k, v = jnp.split(
        proj, [D_CONV, 2 * D_CONV, 3 * D_CONV, 3 * D_CONV + D_ATTN, 3 * D_CONV + 2 * D_ATTN], axis=-1)
    conv_out = short_gated_conv(gate_b, gate_c, conv_in, conv_w)
    def heads(a):
        return a.reshape(b, t, N_ATTN_HEADS, ATTN_HEAD_DIM)
    qh = rmsnorm(heads(q), q_norm_g).transpose(0, 2, 1, 3)
    kh = rmsnorm(heads(k), k_norm_g).transpose(0, 2, 1, 3)
    vh = heads(v).transpose(0, 2, 1, 3)
    attn_out = stick_breaking_attention(qh, kh, vh).transpose(0, 2, 1, 3)
    groups = jnp.concatenate([conv_out.reshape(b, t, CONV_GROUPS, HEAD_DIM_OUT), attn_out], axis=2)
    groups = rmsnorm(groups, jnp.ones((HEAD_DIM_OUT,), jnp.float32))
    mixed = groups.reshape(b, t, D_MIX) * out_norm_g
    return mixed @ w_out


def peer_sublayer(h, norm_g, w_query, sub_keys, expert_u, expert_v):
    b, t, d = h.shape
    n = b * t
    n_pad = -(-n // PEER_TOKEN_BLOCK) * PEER_TOKEN_BLOCK
    tok = jnp.pad(rmsnorm(h, norm_g).reshape(n, d), ((0, n_pad - n), (0, 0)))
    qry = (tok @ w_query).reshape(n_pad, N_PEER_HEADS, 2, D_SUBKEY)
    scores = jnp.einsum('nhpc,pkc->nhpk', qry, sub_keys).astype(jnp.float32)
    s_top, i_top = lax.top_k(scores, PEER_TOPK)
    cand_score = s_top[:, :, 0, :, None] + s_top[:, :, 1, None, :]
    cand_idx = i_top[:, :, 0, :, None] * N_KEYS + i_top[:, :, 1, None, :]
    best, pos = lax.top_k(cand_score.reshape(n_pad, N_PEER_HEADS, PEER_TOPK * PEER_TOPK), PEER_TOPK)
    experts = jnp.take_along_axis(cand_idx.reshape(n_pad, N_PEER_HEADS, PEER_TOPK * PEER_TOPK), pos, axis=-1)
    gates = jax.nn.softmax(best, axis=-1).astype(tok.dtype)

    def block_fn(args):
        xb, eb, gb = args
        u = expert_u[eb]
        vv = expert_v[eb]
        act = jax.nn.gelu(jnp.einsum('thkd,td->thk', u, xb), approximate=False)
        return jnp.einsum('thk,thkd->td', gb * act, vv)

    nb = n_pad // PEER_TOKEN_BLOCK
    out = lax.map(block_fn, (tok.reshape(nb, PEER_TOKEN_BLOCK, d),
                             experts.reshape(nb, PEER_TOKEN_BLOCK, N_PEER_HEADS, PEER_TOPK),
                             gates.reshape(nb, PEER_TOKEN_BLOCK, N_PEER_HEADS, PEER_TOPK)))
    return out.reshape(n_pad, d)[:n].reshape(b, t, d)


def setup_inputs(seed: int = 0) -> dict:
    key = jax.random.key(seed)
    ks = jax.random.split(key, 16)
    f32 = jnp.float32

    def nrm(k, shape, scale):
        return jax.random.normal(k, shape, f32) * scale

    return {
        "x": nrm(ks[0], (BATCH, SEQ, D_MODEL), 1.0),
        "meta_tokens": nrm(ks[1], (N_META, D_MODEL), 1.0),
        "norm_mix_g": 1.0 + nrm(ks[2], (DEPTH, D_MODEL), 0.02),
        "w_in": nrm(ks[3], (DEPTH, D_MODEL, D_IN_PROJ), D_MODEL ** -0.5),
        "conv_w": nrm(ks[4], (DEPTH, CONV_K, D_CONV), CONV_K ** -0.5),
        "q_norm_g": 1.0 + nrm(ks[5], (DEPTH, ATTN_HEAD_DIM), 0.02),
        "k_norm_g": 1.0 + nrm(ks[6], (DEPTH, ATTN_HEAD_DIM), 0.02),
        "out_norm_g": 1.0 + nrm(ks[7], (DEPTH, D_MIX), 0.02),
        "w_out": nrm(ks[8], (DEPTH, D_MIX, D_MODEL), D_MIX ** -0.5),
        "norm_ffn_g": 1.0 + nrm(ks[9], (DEPTH, D_MODEL), 0.02),
        "w_query": nrm(ks[10], (DEPTH, D_MODEL, N_PEER_HEADS * D_QUERY), D_MODEL ** -0.5),
        "sub_keys": nrm(ks[11], (DEPTH, 2, N_KEYS, D_SUBKEY), D_SUBKEY ** -0.5),
        "expert_u": nrm(ks[12], (DEPTH, N_EXPERTS, D_MODEL), D_MODEL ** -0.5),
        "expert_v": nrm(ks[13], (DEPTH, N_EXPERTS, D_MODEL), N_PEER_HEADS ** -0.5),
    }


def reference(x, meta_tokens, norm_mix_g, w_in, conv_w, q_norm_g, k_norm_g, out_norm_g, w_out,
              norm_ffn_g, w_query, sub_keys, expert_u, expert_v):
    b = x.shape[0]
    meta = jnp.broadcast_to(meta_tokens.astype(x.dtype)[None], (b, N_META, D_MODEL))
    h = jnp.concatenate([meta, x], axis=1)
    for layer in range(DEPTH):
        h = h + mixer_sublayer(h, norm_mix_g[layer], w_in[layer], conv_w[layer], q_norm_g[layer],
                               k_norm_g[layer], out_norm_g[layer], w_out[layer])
        h = h + peer_sublayer(h, norm_ffn_g[layer], w_query[layer], sub_keys[layer],
                              expert_u[layer], expert_v[layer])
    return h[:, N_META:]
```

```cpp
#include <hip/hip_runtime.h>
#include <cstdio>
#include <cstdint>

#define DI __device__ __forceinline__
#define LAS __attribute__((address_space(3)))
#define GAS __attribute__((address_space(1)))

#ifndef N_LAUNCH_PER_PHASE
#define N_LAUNCH_PER_PHASE 0
#endif
#ifndef FAST_ATTN
#define FAST_ATTN 1
#endif
#define G3_FP8 0

constexpr int NB = 8, SEQ = 2048, NMETA = 16, TT = SEQ + NMETA  , TP = 2080  ;
constexpr int D = 2048, MR = NB * SEQ  ;
constexpr int DC = 1024, DA = 1024, NH = 8, DH = 128, NPROJ = 6144;
constexpr int PEER_H = 8, PEER_K = 16, NKEYS = 128, NEXP = 16384;
constexpr float EPS = 1e-6f;
constexpr int P_NSL = 8;
constexpr int P_COLS = D / P_NSL;
constexpr int P_RB = D / 2;
constexpr float ATTN_EXIT = 64.0f;
constexpr float QSCALE = 0.08838834764831845f * 1.4426950408889634f;

typedef unsigned short bf16;
typedef float f32x4 __attribute__((ext_vector_type(4)));
typedef float f32x2 __attribute__((ext_vector_type(2)));
typedef unsigned u32x4 __attribute__((ext_vector_type(4)));
typedef unsigned u32x2 __attribute__((ext_vector_type(2)));
typedef int i32x4 __attribute__((ext_vector_type(4)));
typedef int i32x8 __attribute__((ext_vector_type(8)));
typedef short bf16x8 __attribute__((ext_vector_type(8)));
typedef float f32x16 __attribute__((ext_vector_type(16)));
typedef __attribute__((ext_vector_type(2))) __bf16 bf2_t;
typedef _Float16 h16x2 __attribute__((ext_vector_type(2)));
DI unsigned pkh2(float lo, float hi) { f32x2 v = {lo, hi}; h16x2 r = __builtin_convertvector(v, h16x2); return __builtin_bit_cast(unsigned, r); }
DI f32x2 unpkh2(unsigned u) { return __builtin_convertvector(__builtin_bit_cast(h16x2, u), f32x2); }

DI unsigned pk2(float lo, float hi) { f32x2 v = {lo, hi}; bf2_t r = __builtin_convertvector(v, bf2_t); return __builtin_bit_cast(unsigned, r); }
DI bf16 f2bf(float f) { return (bf16)(pk2(f, 0.f) & 0xffffu); }
DI float bf2f(bf16 v) { return __uint_as_float(((unsigned)v) << 16); }
DI float lo_f(unsigned u) { return __uint_as_float(u << 16); }
DI float hi_f(unsigned u) { return __uint_as_float(u & 0xffff0000u); }
DI float wave_sum(float v) {
#pragma unroll
    for (int o = 1; o < 64; o <<= 1) v += __shfl_xor(v, o);
    return v;
}
DI float dot2bf(unsigned a, unsigned b, float acc) { return __builtin_amdgcn_fdot2_f32_bf16(__builtin_bit_cast(bf2_t, a), __builtin_bit_cast(bf2_t, b), acc, false); }

constexpr size_t MiB = 1u << 20;
constexpr size_t WS_CTL = 0, CTL_ZERO_BYTES = 1 * MiB;
constexpr size_t WS_W1T = 1 * MiB;
constexpr size_t WS_WOT = 25 * MiB;
constexpr size_t WS_W2T = 33 * MiB;
constexpr size_t WS_UB = 41 * MiB;
constexpr size_t WS_VB = 73 * MiB;
constexpr size_t WS_MISC = 169 * MiB;
constexpr size_t WS_R0 = WS_MISC, WS_R1 = WS_MISC + 65536, WS_METAB = WS_MISC + 2 * 65536, WS_R0M = WS_MISC + 3 * 65536, WS_METAP = WS_MISC + 4 * 65536  ;
constexpr size_t WS_SS1 = WS_MISC + 1 * MiB;
constexpr size_t WS_SU = WS_MISC + 3 * MiB;
constexpr size_t WS_XSC = WS_MISC + 3 * MiB + 262144;
constexpr size_t WS_SX = WS_MISC + 3 * MiB + 917504;
constexpr size_t WS_TS = WS_MISC + 3 * MiB + 786432;
constexpr size_t WS_XQ = 237 * MiB;
constexpr size_t WS_GB = 173 * MiB, WS_GC = 205 * MiB, WS_CI = 237 * MiB, WS_Q = 269 * MiB;
constexpr size_t WS_H1F8 = 269 * MiB;
constexpr size_t WS_SC = 173 * MiB;
constexpr size_t WS_K = 301 * MiB;
constexpr size_t WS_VT = 334 * MiB;
constexpr size_t WS_H1B = 301 * MiB;
constexpr size_t WS_XB = 367 * MiB;
constexpr size_t WS_MIX = 105 * MiB;
constexpr size_t WS_PAIRS = 431 * MiB;
constexpr size_t WS_PAT = 447 * MiB;
constexpr size_t WS_PD = 173 * MiB;
constexpr size_t WS_END = 455 * MiB;
constexpr int CW_BAR = 4096;
constexpr float MIXQ = 11.2252956f;
constexpr size_t CB_CM2 = 131072 + 32768;
constexpr size_t CB_CM = 131072;
constexpr int CW_Q = 8192;

namespace pg8 {
#define PG8_LAS __attribute__((address_space(3)))
typedef unsigned short bf16_t;
constexpr int BM = 256, BK = 64, HALF = 128, HTB = HALF * BK * 2  , STAGE_BYTES = 8 * HTB, NXCD = 8, WGM = 8;

__host__ __device__ __forceinline__ int lds_byte(int r, int c) { const int st = (r >> 4) * 2 + (c >> 5), rr = r & 15, cc = c & 31, ob = rr * 64 + cc * 2; return st * 1024 + (ob ^ (((ob >> 9) & 1) << 5)); }
__host__ __device__ __forceinline__ void stage_rc(int b, int& R, int& C) { const int st = b / 1024, sb = b % 1024, swz = sb ^ (((sb >> 9) & 1) << 5); R = (st >> 1) * 16 + swz / 64; C = (st & 1) * 32 + (swz % 64) / 2; }
__host__ __device__ __forceinline__ int perm32(int rho) { const int n = rho >> 4, i = rho & 15; return 8 * (i >> 2) + 4 * n + (i & 3); }

struct Unit { int pm, pn; };
struct Gemm { const bf16_t* A; const bf16_t* Bt; int M, N, K; };

struct StaticOrder {
    int nM, nN, nwg, G, c;
    __host__ __device__ void init(int M, int N, int G_, int c_) { nM = M / BM; nN = N / BM; nwg = nM * nN; G = G_; c = c_; }
    __host__ __device__ bool next(int i, Unit& u) const {
        const long L = (long)i * G + c; if (L >= nwg) return false;
        int wgid = (int)L; { const int q = nwg / NXCD, r = nwg % NXCD, xcd = wgid % NXCD, off = wgid / NXCD; wgid = (xcd < r ? xcd * (q + 1) : r * (q + 1) + (xcd - r) * q) + off; }
        const int nig = WGM * nN, gid = wgid / nig, fm = gid * WGM, gsz = (nM - fm) < WGM ? (nM - fm) : WGM;
        u.pm = fm + ((wgid % nig) % gsz); u.pn = (wgid % nig) / gsz; return true;
    }
    __device__ __forceinline__ void a_ready(const Unit&) const {}
    __device__ __forceinline__ void done(const Unit&) const {}
};

template <class Epi, class Sched, bool ALIGN_EPI = false, bool SP2 = false, bool FP8 = false, bool I8 = false>
__device__ __forceinline__ void gemm_phase(PG8_LAS unsigned char* lds, const Gemm g, const Sched& S, const Epi& E) {
    const int tid = threadIdx.x, wid = __builtin_amdgcn_readfirstlane(tid >> 6), lane = tid & 63, wr = wid >> 2, wc = wid & 3, fr = lane & 15, fq = lane >> 4;
    const int K = g.K, nt = K / BK;
    unsigned voffA[2], voffB[2];
#pragma unroll
    for (int i = 0; i < 2; ++i) { int R, C; stage_rc(tid * 16 + i * 8192, R, C); const int Rb = Epi::PERM ? ((R & ~31) + perm32(R & 31)) : R;
        voffA[i] = (unsigned)(R * K + C) * 2u; voffB[i] = (unsigned)(Rb * K + C) * 2u; }
    const size_t kstep = (size_t)(BK * 2);
    const size_t hstep = (size_t)HALF * K * 2;
    const size_t tstep = 2 * hstep;
    const unsigned ldsw = (unsigned)wid * 1024u;
    const int aoff = lds_byte(wr * 64 + fr, fq * 8), boff = lds_byte(wc * 32 + fr, fq * 8);
#define PG8_SA(b, h) (((b) * 2 + (h)) * HTB)
#define PG8_SB(b, h) ((4 + (b) * 2 + (h)) * HTB)
#define PG8_STAGE(bufoff, gbase, voff) do { _Pragma("unroll") for (int _i = 0; _i < 2; ++_i) \
        __builtin_amdgcn_global_load_lds((const unsigned*)((const char*)(gbase) + (voff)[_i]), (PG8_LAS unsigned*)(lds + (bufoff) + ldsw + _i * 8192), 16, 0, 0); } while (0)
#define PG8_LDA(dst, b, h) do { _Pragma("unroll") for (int m = 0; m < 4; ++m) { dst[m].lo = *(const PG8_LAS i32x4*)(lds + PG8_SA(b, h) + aoff + m * 2048); dst[m].hi = *(const PG8_LAS i32x4*)(lds + PG8_SA(b, h) + aoff + m * 2048 + 1024); } } while (0)
#define PG8_LDB(dst, b, h) do { _Pragma("unroll") for (int n = 0; n < 2; ++n) { dst[n].lo = *(const PG8_LAS i32x4*)(lds + PG8_SB(b, h) + boff + n * 2048); dst[n].hi = *(const PG8_LAS i32x4*)(lds + PG8_SB(b, h) + boff + n * 2048 + 1024); } } while (0)
#define PG8_MMA(ai, bj, At, Bt) do { __builtin_amdgcn_s_setprio(1); _Pragma("unroll") for (int m = 0; m < 4; ++m) _Pragma("unroll") for (int n = 0; n < 2; ++n) { \
        if constexpr (FP8) asm volatile("v_mfma_f32_16x16x128_f8f6f4 %0, %1, %2, %0" : "+v"(acc[ai][bj][m][n]) : "v"(Bt[n]), "v"(At[m])); \
        else if constexpr (I8) { acc[ai][bj][m][n] = __builtin_bit_cast(f32x4, __builtin_amdgcn_mfma_i32_16x16x64_i8((i32x4)Bt[n].lo, (i32x4)At[m].lo, __builtin_bit_cast(i32x4, acc[ai][bj][m][n]), 0, 0, 0)); \
               acc[ai][bj][m][n] = __builtin_bit_cast(f32x4, __builtin_amdgcn_mfma_i32_16x16x64_i8((i32x4)Bt[n].hi, (i32x4)At[m].hi, __builtin_bit_cast(i32x4, acc[ai][bj][m][n]), 0, 0, 0)); } \
        else { acc[ai][bj][m][n] = __builtin_amdgcn_mfma_f32_16x16x32_bf16(__builtin_bit_cast(bf16x8, (i32x4)Bt[n].lo), __builtin_bit_cast(bf16x8, (i32x4)At[m].lo), acc[ai][bj][m][n], 0, 0, 0); \
               acc[ai][bj][m][n] = __builtin_amdgcn_mfma_f32_16x16x32_bf16(__builtin_bit_cast(bf16x8, (i32x4)Bt[n].hi), __builtin_bit_cast(bf16x8, (i32x4)At[m].hi), acc[ai][bj][m][n], 0, 0, 0); } } __builtin_amdgcn_s_setprio(0); } while (0)
#define PG8_WAIT_V(n) asm volatile("s_waitcnt vmcnt(" #n ")" ::: "memory")
#define PG8_WAIT_L(n) asm volatile("s_waitcnt lgkmcnt(" #n ")" ::: "memory")
#define PG8_BAR __builtin_amdgcn_s_barrier()
#define PG8_SCHED __builtin_amdgcn_sched_barrier(0)
    Unit cur, nxt; int ui = 0;
    if (!S.next(0, cur)) return;
    f32x4 acc[2][2][4][2];
#pragma unroll
    for (int a = 0; a < 2; ++a)
#pragma unroll
        for (int b = 0; b < 2; ++b)
#pragma unroll
            for (int m = 0; m < 4; ++m)
#pragma unroll
                for (int n = 0; n < 2; ++n) acc[a][b][m][n] = (f32x4){0.f, 0.f, 0.f, 0.f};
    i32x8 At[4], B0[2], B1[2];
    const char* cA = (const char*)g.A + (size_t)cur.pm * tstep; const char* cB = (const char*)g.Bt + (size_t)cur.pn * tstep;
    S.a_ready(cur);
    if constexpr (SP2) {
        PG8_STAGE(PG8_SB(0, 0), cB, voffB); PG8_STAGE(PG8_SB(0, 1), cB + hstep, voffB); PG8_STAGE(PG8_SA(0, 0), cA, voffA); PG8_STAGE(PG8_SA(0, 1), cA + hstep, voffA);
        if (wr == 1) PG8_BAR;
        PG8_WAIT_V(2); PG8_BAR;
        PG8_STAGE(PG8_SB(1, 0), cB + kstep, voffB); PG8_STAGE(PG8_SA(1, 0), cA + kstep, voffA); PG8_STAGE(PG8_SB(1, 1), cB + hstep + kstep, voffB);
        PG8_WAIT_V(6); PG8_BAR;
    } else {
        PG8_STAGE(PG8_SB(0, 0), cB, voffB); PG8_STAGE(PG8_SA(0, 0), cA, voffA); PG8_STAGE(PG8_SB(0, 1), cB + hstep, voffB); PG8_STAGE(PG8_SA(0, 1), cA + hstep, voffA);
        if (wr == 1) PG8_BAR;
        PG8_WAIT_V(4); PG8_BAR;
        PG8_STAGE(PG8_SB(1, 0), cB + kstep, voffB); PG8_STAGE(PG8_SA(1, 0), cA + kstep, voffA); PG8_STAGE(PG8_SB(1, 1), cB + hstep + kstep, voffB);
        PG8_WAIT_V(6); PG8_BAR;
    }
    for (;;) {
        const bool has_next = S.next(ui + 1, nxt);
        const char* nA = has_next ? (const char*)g.A + (size_t)nxt.pm * tstep : cA; const char* nB = has_next ? (const char*)g.Bt + (size_t)nxt.pn * tstep : cB;
        for (int t = 0; t < nt; t += 2) {
            const bool last = (t == nt - 2);
            const char* a1 = cA + (size_t)(t + 1) * kstep;
            const char* a2 = last ? nA : cA + (size_t)(t + 2) * kstep; const char* b2 = last ? nB : cB + (size_t)(t + 2) * kstep;
            const char* a3 = a2 + kstep; const char* b3 = b2 + kstep;
            if (last && has_next) S.a_ready(nxt);
            if constexpr (SP2) {
            PG8_LDB(B0, 0, 0); PG8_LDB(B1, 0, 1); PG8_SCHED; PG8_LDA(At, 0, 0); PG8_STAGE(PG8_SA(1, 1), a1 + hstep, voffA);
            PG8_WAIT_V(8); PG8_WAIT_L(0); PG8_BAR; PG8_MMA(0, 0, At, B0); PG8_MMA(0, 1, At, B1); PG8_BAR; PG8_SCHED;
            PG8_LDA(At, 0, 1); PG8_STAGE(PG8_SB(0, 0), b2, voffB); PG8_STAGE(PG8_SB(0, 1), b2 + hstep, voffB); PG8_STAGE(PG8_SA(0, 0), a2, voffA);
            PG8_WAIT_V(8); PG8_WAIT_L(0); PG8_BAR; PG8_MMA(1, 0, At, B0); PG8_MMA(1, 1, At, B1); PG8_BAR; PG8_SCHED;
            PG8_LDB(B0, 1, 0); PG8_LDB(B1, 1, 1); PG8_SCHED; PG8_LDA(At, 1, 0); PG8_STAGE(PG8_SA(0, 1), a2 + hstep, voffA);
            PG8_WAIT_V(8); PG8_WAIT_L(0); PG8_BAR; PG8_MMA(0, 0, At, B0); PG8_MMA(0, 1, At, B1); PG8_BAR; PG8_SCHED;
            PG8_LDA(At, 1, 1); PG8_STAGE(PG8_SB(1, 0), b3, voffB); PG8_STAGE(PG8_SB(1, 1), b3 + hstep, voffB); PG8_STAGE(PG8_SA(1, 0), a3, voffA);
            PG8_WAIT_V(8); PG8_WAIT_L(0); PG8_BAR; PG8_MMA(1, 0, At, B0); PG8_MMA(1, 1, At, B1); PG8_BAR; PG8_SCHED;
            } else {
            PG8_LDB(B0, 0, 0); PG8_SCHED; PG8_LDA(At, 0, 0); PG8_STAGE(PG8_SA(1, 1), a1 + hstep, voffA);
            PG8_WAIT_L(8); PG8_BAR; PG8_WAIT_L(0); PG8_MMA(0, 0, At, B0); PG8_BAR; PG8_SCHED;
            PG8_LDB(B1, 0, 1); PG8_STAGE(PG8_SB(0, 0), b2, voffB);
            PG8_BAR; PG8_WAIT_L(0); PG8_MMA(0, 1, At, B1); PG8_BAR;
            PG8_LDA(At, 0, 1); PG8_STAGE(PG8_SA(0, 0), a2, voffA);
            PG8_BAR; PG8_WAIT_L(0); PG8_MMA(1, 0, At, B0); PG8_BAR; PG8_SCHED;
            PG8_STAGE(PG8_SB(0, 1), b2 + hstep, voffB);
            PG8_WAIT_V(6); PG8_BAR; PG8_MMA(1, 1, At, B1); PG8_BAR;
            PG8_LDB(B0, 1, 0); PG8_SCHED; PG8_LDA(At, 1, 0); PG8_STAGE(PG8_SA(0, 1), a2 + hstep, voffA);
            PG8_WAIT_L(8); PG8_BAR; PG8_WAIT_L(0); PG8_MMA(0, 0, At, B0); PG8_BAR; PG8_SCHED;
            PG8_LDB(B1, 1, 1); PG8_STAGE(PG8_SB(1, 0), b3, voffB);
            PG8_BAR; PG8_WAIT_L(0); PG8_MMA(0, 1, At, B1); PG8_BAR;
            PG8_LDA(At, 1, 1); PG8_STAGE(PG8_SA(1, 0), a3, voffA);
            PG8_BAR; PG8_WAIT_L(0); PG8_MMA(1, 0, At, B0); PG8_BAR; PG8_SCHED;
            PG8_STAGE(PG8_SB(1, 1), b3 + hstep, voffB);
            PG8_WAIT_V(6); PG8_BAR; PG8_MMA(1, 1, At, B1); PG8_BAR;
            }
        }
        if constexpr (FP8) asm volatile("s_nop 15\n\ts_nop 15" ::: "memory");
        if constexpr (ALIGN_EPI) { if (wr == 0) PG8_BAR; }
        if constexpr (I8) E.dequant(acc, cur, wc, fq);
        E(acc, cur, wr, wc, fr, fq); S.done(cur);
        if (!has_next) break;
#pragma unroll
        for (int a = 0; a < 2; ++a)
#pragma unroll
            for (int b = 0; b < 2; ++b)
#pragma unroll
                for (int m = 0; m < 4; ++m)
#pragma unroll
                    for (int n = 0; n < 2; ++n) acc[a][b][m][n] = (f32x4){0.f, 0.f, 0.f, 0.f};
        cur = nxt; cA = nA; cB = nB; ++ui;
        if constexpr (ALIGN_EPI) { if (wr == 1) PG8_BAR; }
    }
    PG8_WAIT_V(0);
    if constexpr (!ALIGN_EPI) { if (wr == 0) PG8_BAR; }
    PG8_BAR;
#undef PG8_SA
#undef PG8_SB
#undef PG8_STAGE
#undef PG8_LDA
#undef PG8_LDB
#undef PG8_MMA
#undef PG8_WAIT_V
#undef PG8_WAIT_L
#undef PG8_BAR
#undef PG8_SCHED
}
}

#define XB_TMO      128
#define XB_XCNT(j)  (256  + 64 * (j))
#define XB_XSUB(j)  (1280 + 64 * (j))
#define XB_XGEN(j)  (2304 + 64 * (j))
#define XB_TOP      3328
#define XB_TOPGEN   3392
#define XCD_BAR_WORDS 3456
#define XB_SPIN_CAP (1u << 18)
DI unsigned xb_ld(unsigned* p)              { return __hip_atomic_load(p, __ATOMIC_RELAXED, __HIP_MEMORY_SCOPE_AGENT); }
DI unsigned xb_add(unsigned* p, unsigned v) { return __hip_atomic_fetch_add(p, v, __ATOMIC_RELAXED, __HIP_MEMORY_SCOPE_AGENT); }
DI unsigned xb_xcc_id() { return (unsigned)__builtin_amdgcn_s_getreg((3 << 11) | 20) & 0xFu; }
#define XB_SPIN(cond, bar) do { unsigned _sp = 0; while (cond) { __builtin_amdgcn_s_sleep(1); \
    if ((++_sp & 255u) == 0u) { if (xb_ld(&(bar)[XB_TMO])) break; if (_sp > XB_SPIN_CAP) { atomicAdd(&(bar)[XB_TMO], 1u); break; } } } } while (0)
struct XcdBarrier { unsigned* bar; unsigned x; volatile LAS unsigned* st; };
DI XcdBarrier xcd_barrier_post(unsigned* bar, volatile LAS unsigned* st) {
    XcdBarrier b; b.bar = bar; b.x = xb_xcc_id(); b.st = st;
    if (threadIdx.x == 0) (void)xb_add(&bar[XB_XCNT(b.x)], 1u);
    return b;
}
DI void xcd_barrier_complete(unsigned* bar, unsigned x, unsigned& nloc, unsigned& nx) {
    const unsigned G = gridDim.x * gridDim.y * gridDim.z;
    unsigned sum, cnt, mine, sp = 0u;
    for (;;) {
        sum = 0u; cnt = 0u; mine = 0u;
#pragma unroll
        for (unsigned j = 0; j < 16; ++j) { const unsigned c = xb_ld(&bar[XB_XCNT(j)]); sum += c; cnt += (c > 0u) ? 1u : 0u; mine = (j == x) ? c : mine; }
        if (sum == G) break;
        __builtin_amdgcn_s_sleep(1);
        if ((++sp & 255u) == 0u) { if (xb_ld(&bar[XB_TMO])) break; if (sp > XB_SPIN_CAP) { atomicAdd(&bar[XB_TMO], 1u); break; } }
    }
    nloc = mine > 0u ? mine : 1u; nx = cnt > 0u ? cnt : 1u;
}
DI void xcd_barrier(const XcdBarrier& b) {
    asm volatile("s_waitcnt vmcnt(0)" ::: "memory");
    __syncthreads();
    if (threadIdx.x == 0) {
        unsigned* bar = b.bar;
        __builtin_amdgcn_s_waitcnt(0);
        unsigned nloc = b.st[0], nx = b.st[1];
        if (nloc == 0u) { xcd_barrier_complete(bar, b.x, nloc, nx); b.st[0] = nloc; b.st[1] = nx; }
        const unsigned old = xb_add(&bar[XB_XSUB(b.x)], 1u);
        const unsigned gen = old / nloc;
        if (old + 1u == (gen + 1u) * nloc) {
            __builtin_amdgcn_fence(__ATOMIC_RELEASE, "agent");
            asm volatile("s_waitcnt vmcnt(0)" ::: "memory");
            const unsigned og = xb_add(&bar[XB_TOP], 1u);
            const unsigned tg = og / nx;
            if (og + 1u == (tg + 1u) * nx) xb_add(&bar[XB_TOPGEN], 1u);
            else XB_SPIN(xb_ld(&bar[XB_TOPGEN]) == tg, bar);
            __builtin_amdgcn_fence(__ATOMIC_ACQUIRE, "agent");
            xb_add(&bar[XB_XGEN(b.x)], 1u);
            asm volatile("s_waitcnt vmcnt(0)" ::: "memory");
        } else {
            XB_SPIN(xb_ld(&bar[XB_XGEN(b.x)]) == gen, bar);
            __builtin_amdgcn_fence(__ATOMIC_ACQUIRE, "agent");
            asm volatile("s_waitcnt vmcnt(0)" ::: "memory");
        }
    }
    __syncthreads();
}

constexpr int NWAVES = 8, NTHREADS = 512;
constexpr int RING_BYTES = 131072, LDSCTL_OFF = RING_BYTES, LDS_BYTES = 147456;
struct Args { const float* in[14]; float* out; unsigned char* ws; int ph_lo, ph_hi; };
struct Frame {
    LAS unsigned char* lds;
    int tid, lane, wave, G, gw, NGW;
    const float *x, *meta, *g_mix, *w_in, *conv_w, *g_q, *g_k, *g_out, *w_out, *g_ffn, *w_query, *sub_keys, *eu, *ev;
    float* out; unsigned char* ws;
};
template <class T> DI T* wsp(const Frame& F, size_t off) { return (T*)(F.ws + off); }

DI unsigned q8(float f) { return (unsigned)__float2int_rn(f) & 255u; }
DI unsigned q8s(float f) { return (unsigned)__float2int_rn(__builtin_amdgcn_fmed3f(f, -127.0f, 127.0f)) & 255u; }
struct RowRegs { f32x4 v[4][2]; };
DI void row_load(RowRegs& r, const float* src, int lane) {
#pragma unroll
    for (int c = 0; c < 4; ++c)
#pragma unroll
        for (int h = 0; h < 2; ++h) r.v[c][h] = *(const f32x4*)(src + c * 512 + lane * 8 + 4 * h);
}
DI void row_to_i8(const float* src, unsigned char* dst, float* rf_out, float* sx_out, int lane) {
    RowRegs r; row_load(r, src, lane);
    float ss = 0.f, mx = 0.f;
#pragma unroll
    for (int c = 0; c < 4; ++c)
#pragma unroll
        for (int h = 0; h < 2; ++h) { const f32x4 a = r.v[c][h]; ss += (a.x * a.x + a.y * a.y) + (a.z * a.z + a.w * a.w); mx = fmaxf(mx, fmaxf(fmaxf(fabsf(a.x), fabsf(a.y)), fmaxf(fabsf(a.z), fabsf(a.w)))); }
    ss = wave_sum(ss);
#pragma unroll
    for (int o = 1; o < 64; o <<= 1) mx = fmaxf(mx, __shfl_xor(mx, o));
    const float inv = mx > 0.f ? 127.0f / mx : 0.f;
#pragma unroll
    for (int c = 0; c < 4; ++c) { const f32x4 a = r.v[c][0] * inv, b = r.v[c][1] * inv;
        u32x2 o; o.x = q8(a.x) | (q8(a.y) << 8) | (q8(a.z) << 16) | (q8(a.w) << 24); o.y = q8(b.x) | (q8(b.y) << 8) | (q8(b.z) << 16) | (q8(b.w) << 24);
        *(u32x2*)(dst + c * 512 + lane * 8) = o; }
    if (lane == 0) { *rf_out = (1.0f / sqrtf(ss * (1.0f / D) + EPS)) * (mx * (1.0f / 127.0f)); *sx_out = mx * (1.0f / 127.0f); }
}
DI void row_to_o4(const RowRegs& r, unsigned char* dst, float* scale_out, int lane) {
    float mx = 0.f;
#pragma unroll
    for (int c = 0; c < 4; ++c)
#pragma unroll
        for (int h = 0; h < 2; ++h) { const f32x4 a = r.v[c][h]; mx = fmaxf(mx, fmaxf(fmaxf(fabsf(a.x), fabsf(a.y)), fmaxf(fabsf(a.z), fabsf(a.w)))); }
#pragma unroll
    for (int o = 1; o < 64; o <<= 1) mx = fmaxf(mx, __shfl_xor(mx, o));
    const float sc = mx > 0.f ? mx * (0.72f / 7.0f) : 1.0f, inv = 1.0f / sc;
#pragma unroll
    for (int c = 0; c < 4; ++c) { unsigned w = 0u;
#pragma unroll
        for (int k = 0; k < 8; ++k) { const float f = r.v[c][k >> 2][k & 3] * inv; int q = __float2int_rn(f); q = q < -7 ? -7 : (q > 7 ? 7 : q);
            const int nib = (k & 1) ? 4 + (k >> 1) : (k >> 1); w |= (unsigned)(q + 8) << (4 * nib); }
        *(unsigned*)(dst + c * 256 + lane * 4) = w; }
    if (lane == 0) *scale_out = sc;
}
DI void row_to_i4(const RowRegs& r, const float* gain, unsigned char* dst, float* scale_out, int lane) {
    f32x4 v[4][2]; float mx = 0.f;
#pragma unroll
    for (int c = 0; c < 4; ++c)
#pragma unroll
        for (int h = 0; h < 2; ++h) { const int e0 = c * 512 + lane * 8 + 4 * h; f32x4 a = r.v[c][h];
            if (gain) a = a * *(const f32x4*)(gain + e0);
            v[c][h] = a; mx = fmaxf(mx, fmaxf(fmaxf(fabsf(a.x), fabsf(a.y)), fmaxf(fabsf(a.z), fabsf(a.w)))); }
#pragma unroll
    for (int o = 1; o < 64; o <<= 1) mx = fmaxf(mx, __shfl_xor(mx, o));
    const float sc = mx > 0.f ? mx * (0.72f / 7.0f) : 1.0f, inv = 1.0f / sc;
#pragma unroll
    for (int c = 0; c < 4; ++c) { unsigned w = 0u;
#pragma unroll
        for (int k = 0; k < 8; ++k) { const float f = v[c][k >> 2][k & 3] * inv; int q = __float2int_rn(f); q = q < -7 ? -7 : (q > 7 ? 7 : q); w |= ((unsigned)q & 15u) << (4 * k); }
        *(unsigned*)(dst + c * 256 + lane * 4) = w; }
    if (lane == 0) *scale_out = sc;
}
struct XqRegs { u32x4 v[4]; };
DI void xq_load(XqRegs& r, const bf16* src, int lane) {
#pragma unroll
    for (int i = 0; i < 4; ++i) r.v[i] = *(const u32x4*)(src + lane * 32 + 8 * i);
}
DI void row_to_xq(const XqRegs& r, unsigned char* dst, float* xsc, int lane) {
    float f[32]; float mx = 0.f;
#pragma unroll
    for (int i = 0; i < 4; ++i) { const u32x4 v = r.v[i];
        f[8 * i] = lo_f(v.x); f[8 * i + 1] = hi_f(v.x); f[8 * i + 2] = lo_f(v.y); f[8 * i + 3] = hi_f(v.y); f[8 * i + 4] = lo_f(v.z); f[8 * i + 5] = hi_f(v.z); f[8 * i + 6] = lo_f(v.w); f[8 * i + 7] = hi_f(v.w); }
#pragma unroll
    for (int i = 0; i < 32; ++i) mx = fmaxf(mx, fabsf(f[i]));
    mx = fmaxf(mx, __shfl_xor(mx, 1)); mx = fmaxf(mx, __shfl_xor(mx, 2)); mx = fmaxf(mx, __shfl_xor(mx, 4));
    const float sc = mx > 0.f ? mx * (1.0f / 119.0f) : 1.0f, inv = 1.0f / sc;
    u32x4 wh, wl;
#pragma unroll
    for (int d = 0; d < 4; ++d) { unsigned h = 0u, l = 0u;
#pragma unroll
        for (int k = 0; k < 8; ++k) { const int q = __float2int_rn(f[8 * d + k] * inv); const int qh = (q + 8) >> 4, ql = q - 16 * qh;
            h |= ((unsigned)qh & 15u) << (4 * k); l |= ((unsigned)ql & 15u) << (4 * k); }
        wh[d] = h; wl[d] = l; }
    unsigned char* p = dst + (lane >> 3) * 256 + (lane & 7) * 16;
    *(u32x4*)p = wh; *(u32x4*)(p + 128) = wl;
    if ((lane & 7) == 0) xsc[lane >> 3] = sc;
}
constexpr float W2_SCALE = 64.0f;
DI void p0_fold_item(const float* wq, const float* subk, const float* g, unsigned char* W2T, int t, int lane) {
    const int hp = t >> 8, kkb = (t >> 6) & 3, kmb = t & 63, p = hp & 1, r = lane & 31, h = lane >> 5;
    const float* ap = subk + (size_t)(p * 128 + kkb * 32 + r) * 128 + 2 * h;
    const float* bp = wq + (size_t)(kmb * 32 + r) * 2048 + hp * 128 + 2 * h;
    f32x16 acc;
#pragma unroll
    for (int i = 0; i < 16; ++i) acc[i] = 0.f;
#pragma unroll 8
    for (int q = 0; q < 32; ++q) { const f32x2 a = *(const f32x2*)(ap + 4 * q), b = *(const f32x2*)(bp + 4 * q);
        acc = __builtin_amdgcn_mfma_f32_32x32x2f32(a.x, b.x, acc, 0, 0, 0); acc = __builtin_amdgcn_mfma_f32_32x32x2f32(a.y, b.y, acc, 0, 0, 0); }
    const int km = kmb * 32 + r; const float gk = g[km];
#if G3_FP8
    unsigned char* dst = W2T + (size_t)(hp * 128 + kkb * 32 + 4 * h) * 2048 + km;
#pragma unroll
    for (int i = 0; i < 16; ++i) { const float v = acc[i] * gk * W2_SCALE; dst[(size_t)((i & 3) + 8 * (i >> 2)) * 2048] = (unsigned char)(__builtin_amdgcn_cvt_pk_fp8_f32(v, v, 0, false) & 0xff); }
#else
    bf16* dst = (bf16*)W2T + (size_t)(hp * 128 + kkb * 32 + 4 * h) * 2048 + km;
#pragma unroll
    for (int i = 0; i < 16; ++i) dst[(size_t)((i & 3) + 8 * (i >> 2)) * 2048] = f2bf(acc[i] * gk * W2_SCALE);
#endif
}
DI void p0_panel(Frame& F, int p) {
    const bool first = p < NPROJ / 32;
    const float* W = first ? F.w_in : F.w_out; const float* g = first ? F.g_mix : F.g_out; const int N = first ? NPROJ : D, n0 = 32 * (first ? p : p - NPROJ / 32);
    int ns = n0;
    if (first && n0 >= 1024 && n0 < 3072) { const int t = n0 - 1024, w = t & 255; ns = ((w >> 7) ? 2048 : 1024) + 128 * (t >> 8) + (w & 127); }
    unsigned* CM = (unsigned*)(F.ws + WS_CTL + (first ? CB_CM : CB_CM2)); unsigned char* WT = F.ws + (first ? WS_W1T : WS_WOT); const float f_lo = first ? 1.0f : 2.0f;
    LAS unsigned char* img = F.lds; LAS float* part = (LAS float*)(F.lds + LDSCTL_OFF + 1024);
    const int lane = F.lane, r8 = lane >> 3, c4 = lane & 7;
    f32x4 m = {0.f, 0.f, 0.f, 0.f};
#pragma unroll 4
    for (int it = 0; it < 32; ++it) { const int k = F.wave * 256 + it * 8 + r8;
        const f32x4 v = *(const f32x4*)(W + (size_t)k * N + ns + 4 * c4) * (g[k] * (k < 1024 ? f_lo : 1.0f));
        m.x = fmaxf(m.x, fabsf(v.x)); m.y = fmaxf(m.y, fabsf(v.y)); m.z = fmaxf(m.z, fabsf(v.z)); m.w = fmaxf(m.w, fabsf(v.w));
#pragma unroll
        for (int j = 0; j < 4; ++j) *(LAS bf16*)(img + (4 * c4 + j) * 4096 + ((k * 2) ^ (c4 * 8))) = f2bf(v[j]); }
#pragma unroll
    for (int j = 0; j < 4; ++j) { float t = m[j]; t = fmaxf(t, __shfl_xor(t, 8)); t = fmaxf(t, __shfl_xor(t, 16)); t = fmaxf(t, __shfl_xor(t, 32)); if (r8 == 0) part[F.wave * 32 + 4 * c4 + j] = t; }
    __syncthreads();
#pragma unroll
    for (int i = 0; i < 4; ++i) { const int n = F.wave * 4 + i, q4 = (n >> 2) & 7;
        float cm = 0.f;
#pragma unroll
        for (int w = 0; w < 8; ++w) cm = fmaxf(cm, part[w * 32 + n]);
        const float inv = cm > 0.f ? 127.0f / cm : 0.f;
        unsigned o[8];
#pragma unroll
        for (int c = 0; c < 8; ++c) { const u32x2 b = *(const LAS u32x2*)(img + n * 4096 + ((lane * 64 + c * 8) ^ (q4 * 8)));
            o[c] = q8(lo_f(b.x) * inv) | (q8(hi_f(b.x) * inv) << 8) | (q8(lo_f(b.y) * inv) << 16) | (q8(hi_f(b.y) * inv) << 24); }
        unsigned char* dst = WT + (size_t)(n0 + n) * D + lane * 32;
        *(u32x4*)dst = (u32x4){o[0], o[1], o[2], o[3]}; *(u32x4*)(dst + 16) = (u32x4){o[4], o[5], o[6], o[7]};
        if (lane == 0) CM[n0 + n] = __float_as_uint(cm);
    }
    if (first) {
        unsigned wq[4][16];
#pragma unroll
        for (int i = 0; i < 4; ++i) { const int n = F.wave * 4 + i, q4 = (n >> 2) & 7;
#pragma unroll
            for (int c = 0; c < 8; ++c) { const u32x2 b = *(const LAS u32x2*)(img + n * 4096 + ((lane * 64 + c * 8) ^ (q4 * 8))); wq[i][2 * c] = b.x; wq[i][2 * c + 1] = b.y; } }
        float* MP = wsp<float>(F, WS_METAP);
        for (int r = 0; r < NMETA; ++r) {
            float a[4] = {0.f, 0.f, 0.f, 0.f}, ss = 0.f;
#pragma unroll
            for (int c = 0; c < 8; ++c) { const f32x4 mv = *(const f32x4*)(F.meta + (size_t)r * D + lane * 32 + 4 * c);
                ss += (mv.x * mv.x + mv.y * mv.y) + (mv.z * mv.z + mv.w * mv.w);
#pragma unroll
                for (int i = 0; i < 4; ++i) a[i] += (mv.x * lo_f(wq[i][2 * c]) + mv.y * hi_f(wq[i][2 * c])) + (mv.z * lo_f(wq[i][2 * c + 1]) + mv.w * hi_f(wq[i][2 * c + 1])); }
            ss = wave_sum(ss); const float r0m = 1.0f / sqrtf(ss * (1.0f / D) + EPS);
#pragma unroll
            for (int i = 0; i < 4; ++i) { const float t = wave_sum(a[i]); if (lane == 0) MP[(size_t)r * NPROJ + ns + F.wave * 4 + i] = t * r0m; }
        }
    }
    __syncthreads();
}
DI void p0_prep(Frame& F) {
    for (int p = blockIdx.x; p < NPROJ / 32 + D / 32; p += F.G) p0_panel(F, p);
    constexpr int I_FOLD = 16 * 4 * 64;
    constexpr int NT = I_FOLD + 128   + MR  ;
    for (int it0 = F.gw; it0 < NT; it0 += F.NGW) {
        int r = (F.wave & 1) ? (NT - it0) : it0;
        static_assert(NT % 2 == 0, "item count parity");
        if (r < I_FOLD) { p0_fold_item(F.w_query, F.sub_keys, F.g_ffn, wsp<unsigned char>(F, WS_W2T), r, F.lane); continue; } r -= I_FOLD;
        if (r < 128) { f32x4* z = (f32x4*)(F.ws + WS_SS1 + (size_t)r * 16384);
#pragma unroll
          for (int i = 0; i < 16; ++i) z[i * 64 + F.lane] = (f32x4){0.f, 0.f, 0.f, 0.f};
          continue; } r -= 128;
        row_to_i8(F.x + (size_t)r * D, wsp<unsigned char>(F, WS_XB) + (size_t)r * D, wsp<float>(F, WS_R0) + r, wsp<float>(F, WS_SX) + r, F.lane);
    }
}
DI void table_rows(Frame& F, int which) {
    unsigned char* V4 = wsp<unsigned char>(F, WS_VB); unsigned char* U4 = wsp<unsigned char>(F, WS_UB);
    for (int blk = blockIdx.x; blk < NEXP / 64; blk += F.G) {
        const int r0 = blk * 64 + F.wave * 8;
        if (which == 2 || which == 4) {
            const float* tab = which == 2 ? F.eu : F.ev;
            RowRegs cur, nx1, nx2; row_load(cur, tab + (size_t)r0 * D, F.lane); row_load(nx1, tab + (size_t)(r0 + 1) * D, F.lane);
            for (int rr = 0; rr < 8; ++rr) { const int e = r0 + rr;
                if (rr < 6) row_load(nx2, tab + (size_t)(e + 2) * D, F.lane);
                if (which == 2) row_to_i4(cur, F.g_ffn, U4 + (size_t)e * P_RB, wsp<float>(F, WS_SU) + 2 * e, F.lane);
                else row_to_o4(cur, V4 + (size_t)e * P_RB, wsp<float>(F, WS_SU) + 2 * e + 1, F.lane);
                cur = nx1; nx1 = nx2; }
        }
        if (which == 6) { XqRegs c, n1, n2; const bf16* hb = wsp<bf16>(F, WS_H1B); xq_load(c, hb + (size_t)r0 * D, F.lane); xq_load(n1, hb + (size_t)(r0 + 1) * D, F.lane);
            for (int rr = 0; rr < 8; ++rr) { const int t = r0 + rr;
                if (rr < 6) xq_load(n2, hb + (size_t)(t + 2) * D, F.lane);
                row_to_xq(c, wsp<unsigned char>(F, WS_XQ) + (size_t)t * 2048, wsp<float>(F, WS_XSC) + (size_t)t * 8, F.lane);
                c = n1; n1 = n2; } }
    }
}

DI size_t k_off(int b, int kidx, int head, int d) { return ((((((size_t)(b * NH + head) * 65 + (kidx >> 5)) * 8 + (d >> 4)) * 2 + ((d >> 3) & 1)) * 32 + (kidx & 31)) * 8) + (d & 7); }
struct EpiG1 {
    static constexpr bool PERM = true, AFTER_DRAIN = false;
    const float* R0; bf16 *GBp, *GCp, *CIp, *Qp, *Kp, *VTp; const float *GQ, *GK; LAS float* PT; const unsigned* CM;
    DI void dequant(f32x4 (&acc)[2][2][4][2], const pg8::Unit& u, int wc, int fq) const {
        const unsigned* cm = CM + u.pn * 256 + wc * 32 + 8 * fq;
#pragma unroll
        for (int bj = 0; bj < 2; ++bj)
#pragma unroll
            for (int n = 0; n < 2; ++n) { const u32x4 cb = *(const u32x4*)(cm + 128 * bj + 4 * n);
                const f32x4 cs = (f32x4){__uint_as_float(cb.x), __uint_as_float(cb.y), __uint_as_float(cb.z), __uint_as_float(cb.w)} * (1.0f / 127.0f);
#pragma unroll
                for (int ai = 0; ai < 2; ++ai)
#pragma unroll
                    for (int m = 0; m < 4; ++m) { const i32x4 iv = __builtin_bit_cast(i32x4, acc[ai][bj][m][n]);
                        acc[ai][bj][m][n] = (f32x4){(float)iv[0], (float)iv[1], (float)iv[2], (float)iv[3]} * cs; } }
    }
    DI void operator()(const f32x4 (&acc)[2][2][4][2], const pg8::Unit& u, int wr, int wc, int fr, int fq) const {
        const int seg = u.pn >> 2, colt = (u.pn & 3) * 256 + wc * 32 + 8 * fq;
        const int row0 = u.pm * 256 + wr * 64 + fr, b = row0 >> 11;
        if (seg == 3 || seg == 4) {
#pragma unroll
            for (int ai = 0; ai < 2; ++ai)
#pragma unroll
                for (int m = 0; m < 4; ++m) { const float rs = R0[row0 + ai * 128 + m * 16];
#pragma unroll
                    for (int bj = 0; bj < 2; ++bj) { const f32x4 v0 = acc[ai][bj][m][0] * rs, v1 = acc[ai][bj][m][1] * rs;
                        float ss = (v0[0] * v0[0] + v0[1] * v0[1]) + (v0[2] * v0[2] + v0[3] * v0[3]) + (v1[0] * v1[0] + v1[1] * v1[1]) + (v1[2] * v1[2] + v1[3] * v1[3]);
                        ss += __shfl_xor(ss, 16); ss += __shfl_xor(ss, 32);
                        if (fq == 0) PT[(ai * 128 + wr * 64 + m * 16 + fr) * 8 + bj * 4 + wc] = ss; } }
            asm volatile("s_waitcnt lgkmcnt(0)" ::: "memory"); __builtin_amdgcn_s_barrier(); asm volatile("" ::: "memory");
            const float* gsrc = (seg == 3 ? GQ : GK) + wc * 32 + 8 * fq; const float sc = (seg == 3) ? QSCALE : 1.0f;
            const f32x4 g0 = *(const f32x4*)gsrc, g1 = *(const f32x4*)(gsrc + 4);
            bf16* base = (seg == 3) ? Qp : Kp; const int radd = (seg == 4) ? (b * (TP - SEQ) + NMETA) : 0;
#pragma unroll
            for (int ai = 0; ai < 2; ++ai)
#pragma unroll
                for (int m = 0; m < 4; ++m) { const int row = row0 + ai * 128 + m * 16; bf16* rowp = base + (size_t)(row + radd) * 1024 + colt;
#pragma unroll
                    for (int bj = 0; bj < 2; ++bj) { const f32x4 pq = *(const LAS f32x4*)(PT + (ai * 128 + wr * 64 + m * 16 + fr) * 8 + bj * 4);
                        const float rn = R0[row] * sc / sqrtf(((pq[0] + pq[1]) + (pq[2] + pq[3])) * (1.0f / DH) + EPS);
                        const f32x4 v0 = acc[ai][bj][m][0] * rn * g0, v1 = acc[ai][bj][m][1] * rn * g1;
                        u32x4 w; w.x = pk2(v0[0], v0[1]); w.y = pk2(v0[2], v0[3]); w.z = pk2(v1[0], v1[1]); w.w = pk2(v1[2], v1[3]);
                        if (seg == 4) *(u32x4*)(Kp + k_off(b, NMETA + (row & 2047), 2 * (u.pn & 3) + bj, wc * 32 + 8 * fq)) = w;
                        else *(u32x4*)(rowp + bj * 128) = w; } }
        } else {
        bf16* base = GBp + (size_t)seg * ((WS_GC - WS_GB) / 2);
#pragma unroll
        for (int ai = 0; ai < 2; ++ai)
#pragma unroll
            for (int m = 0; m < 4; ++m) {
                const int row = row0 + ai * 128 + m * 16; const float rs = R0[row];
                if (seg == 0) {
                    bf16* rowp = base + (size_t)row * 1024 + colt;
#pragma unroll
                    for (int bj = 0; bj < 2; ++bj) { const f32x4 v0 = acc[ai][bj][m][0] * rs, v1 = acc[ai][bj][m][1] * rs;
                        u32x4 w; w.x = pk2(v0[0], v0[1]); w.y = pk2(v0[2], v0[3]); w.z = pk2(v1[0], v1[1]); w.w = pk2(v1[2], v1[3]);
                        *(u32x4*)(rowp + bj * 128) = w; }
                } else if (seg < 3) {
                    const float rs2 = rs * rs; const f32x4 v0 = acc[ai][0][m][0] * acc[ai][1][m][0] * rs2, v1 = acc[ai][0][m][1] * acc[ai][1][m][1] * rs2;
                    u32x4 w; w.x = pk2(v0[0], v0[1]); w.y = pk2(v0[2], v0[3]); w.z = pk2(v1[0], v1[1]); w.w = pk2(v1[2], v1[3]);
                    *(u32x4*)(GCp + (size_t)row * 1024 + (u.pn - 4) * 128 + wc * 32 + 8 * fq) = w;
                } else {
                    const int s = row & 2047;
#pragma unroll
                    for (int bj = 0; bj < 2; ++bj) { const int c = colt + bj * 128;
                        bf16* p = VTp + ((size_t)(b * NH + (c >> 7)) * DH + (c & 127)) * TP + NMETA + s;
#pragma unroll
                        for (int n = 0; n < 2; ++n)
#pragma unroll
                            for (int j = 0; j < 4; ++j) p[(size_t)(n * 4 + j) * TP] = f2bf(acc[ai][bj][m][n][j] * rs); }
                }
            }
        }
    }
};
struct EpiG2 {
    static constexpr bool PERM = true, AFTER_DRAIN = false;
    const unsigned char* X8; const float* SX; bf16* H1B; float* SS1; unsigned char* H1F8; const unsigned* CM;
    DI void dequant(f32x4 (&acc)[2][2][4][2], const pg8::Unit& u, int wc, int fq) const {
        const unsigned* cm = CM + u.pn * 256 + wc * 32 + 8 * fq;
#pragma unroll
        for (int bj = 0; bj < 2; ++bj)
#pragma unroll
            for (int n = 0; n < 2; ++n) { const u32x4 cb = *(const u32x4*)(cm + 128 * bj + 4 * n);
                const f32x4 cs = (f32x4){__uint_as_float(cb.x), __uint_as_float(cb.y), __uint_as_float(cb.z), __uint_as_float(cb.w)} * (1.0f / (127.0f * 2.0f * MIXQ));
#pragma unroll
                for (int ai = 0; ai < 2; ++ai)
#pragma unroll
                    for (int m = 0; m < 4; ++m) { const i32x4 iv = __builtin_bit_cast(i32x4, acc[ai][bj][m][n]);
                        acc[ai][bj][m][n] = (f32x4){(float)iv[0], (float)iv[1], (float)iv[2], (float)iv[3]} * cs; } }
    }
    DI void operator()(const f32x4 (&acc)[2][2][4][2], const pg8::Unit& u, int wr, int wc, int fr, int fq) const {
        const int col0 = u.pn * 256 + wc * 32 + 8 * fq, row0 = u.pm * 256 + wr * 64 + fr;
#pragma unroll
        for (int ai = 0; ai < 2; ++ai)
#pragma unroll
            for (int m = 0; m < 4; ++m) {
                const int row = row0 + ai * 128 + m * 16; float ss = 0.f; const float sx = SX[row];
#pragma unroll
                for (int bj = 0; bj < 2; ++bj) { const size_t off = (size_t)row * D + col0 + bj * 128;
                    const u32x2 xq = *(const u32x2*)(X8 + off);
                    const f32x4 x0 = (f32x4){(float)(int)(signed char)xq.x, (float)(int)(signed char)(xq.x >> 8), (float)(int)(signed char)(xq.x >> 16), (float)((int)xq.x >> 24)} * sx,
                                x1 = (f32x4){(float)(int)(signed char)xq.y, (float)(int)(signed char)(xq.y >> 8), (float)(int)(signed char)(xq.y >> 16), (float)((int)xq.y >> 24)} * sx;
                    const f32x4 h0 = x0 + acc[ai][bj][m][0], h1 = x1 + acc[ai][bj][m][1];
                    u32x4 w; w.x = pk2(h0[0], h0[1]); w.y = pk2(h0[2], h0[3]); w.z = pk2(h1[0], h1[1]); w.w = pk2(h1[2], h1[3]);
                    *(u32x4*)(H1B + off) = w;
                    if (G3_FP8) { unsigned f0 = __builtin_amdgcn_cvt_pk_fp8_f32(h0[0], h0[1], 0, false); f0 = __builtin_amdgcn_cvt_pk_fp8_f32(h0[2], h0[3], f0, true);
                      unsigned f1 = __builtin_amdgcn_cvt_pk_fp8_f32(h1[0], h1[1], 0, false); f1 = __builtin_amdgcn_cvt_pk_fp8_f32(h1[2], h1[3], f1, true);
                      *(u32x2*)(H1F8 + off) = (u32x2){f0, f1}; }
                    ss += (h0[0] * h0[0] + h0[1] * h0[1]) + (h0[2] * h0[2] + h0[3] * h0[3]) + (h1[0] * h1[0] + h1[1] * h1[1]) + (h1[2] * h1[2] + h1[3] * h1[3]); }
                ss += __shfl_xor(ss, 16); ss += __shfl_xor(ss, 32);
                if (fq == 0) SS1[(size_t)(u.pn * 4 + wc) * MR + row] = ss;
            }
    }
};
struct EpiG3 {
    static constexpr bool PERM = true, AFTER_DRAIN = false;
    unsigned short* SC;
    DI void operator()(const f32x4 (&acc)[2][2][4][2], const pg8::Unit& u, int wr, int wc, int fr, int fq) const {
        const int row0 = u.pm * 256 + wr * 64 + fr;
#pragma unroll
        for (int ai = 0; ai < 2; ++ai)
#pragma unroll
            for (int m = 0; m < 4; ++m) { const int tok = row0 + ai * 128 + m * 16;
                unsigned short* rowp = SC + ((size_t)((tok >> 6) * 8 + u.pn) * 32 * 64 + (tok & 63)) * 8 + (size_t)(4 * wc + fq) * 512;
#pragma unroll
                for (int bj = 0; bj < 2; ++bj) { const f32x4 v0 = acc[ai][bj][m][0] * (1.0f / W2_SCALE), v1 = acc[ai][bj][m][1] * (1.0f / W2_SCALE);
                    u32x4 w; w.x = pkh2(v0[0], v0[1]); w.y = pkh2(v0[2], v0[3]); w.z = pkh2(v1[0], v1[1]); w.w = pkh2(v1[2], v1[3]);
                    *(u32x4*)(rowp + bj * (16 * 512)) = w; } }
    }
};

DI float sum16(float v) { v += __shfl_xor(v, 1); v += __shfl_xor(v, 2); v += __shfl_xor(v, 4); v += __shfl_xor(v, 8); return v; }
DI void unpack8(const u32x4 v, float (&f)[8]) { f[0] = lo_f(v.x); f[1] = hi_f(v.x); f[2] = lo_f(v.y); f[3] = hi_f(v.y); f[4] = lo_f(v.z); f[5] = hi_f(v.z); f[6] = lo_f(v.w); f[7] = hi_f(v.w); }
DI u32x4 pack8(const float (&f)[8]) { u32x4 o; o.x = pk2(f[0], f[1]); o.y = pk2(f[2], f[3]); o.z = pk2(f[4], f[5]); o.w = pk2(f[6], f[7]); return o; }
template <int MODE  >
DI void p2_norm_conv(Frame& F) {
    bf16* GBp = wsp<bf16>(F, WS_GB); bf16* GCp = wsp<bf16>(F, WS_GC); bf16* CIp = wsp<bf16>(F, WS_CI); bf16* Qp = wsp<bf16>(F, WS_Q); bf16* Kp = wsp<bf16>(F, WS_K);
    bf16* VTp = wsp<bf16>(F, WS_VT); unsigned char* MIX = wsp<unsigned char>(F, WS_MIX); const float* MP = wsp<float>(F, WS_METAP);
    const int lane = F.lane;
    constexpr int NRUN = MR / 8;
    constexpr int NT = NRUN + NB * NMETA   + NB * NMETA   + NB * NH  ;
    for (int it = (MODE == 0 ? F.gw : NRUN + F.gw); it < (MODE == 0 ? NRUN : NT); it += F.NGW) {
        int r = it;
        if (r < NRUN) {
            const int m0 = r * 8, s0 = m0 & 2047;
            float w0[2][8], w1[2][8], w2[2][8], u1[2][8], u2[2][8];
#pragma unroll
            for (int c = 0; c < 2; ++c) { const int ch = c * 512 + lane * 8;
#pragma unroll
                for (int j = 0; j < 8; ++j) { w0[c][j] = F.conv_w[ch + j]; w1[c][j] = F.conv_w[DC + ch + j]; w2[c][j] = F.conv_w[2 * DC + ch + j]; }
                if (s0 == 0) {
#pragma unroll
                    for (int j = 0; j < 8; ++j) { u2[c][j] = MP[(size_t)14 * NPROJ + 1024 + ch + j] * MP[(size_t)14 * NPROJ + 2048 + ch + j];
                                                  u1[c][j] = MP[(size_t)15 * NPROJ + 1024 + ch + j] * MP[(size_t)15 * NPROJ + 2048 + ch + j]; }
                } else {
                    unpack8(*(const u32x4*)(GCp + (size_t)(m0 - 2) * 1024 + ch), u2[c]);
                    unpack8(*(const u32x4*)(GCp + (size_t)(m0 - 1) * 1024 + ch), u1[c]);
                }
            }
            for (int tk = 0; tk < 8; ++tk) {
                const int m = m0 + tk, b = m >> 11, s = m & 2047;
#pragma unroll
                for (int c = 0; c < 2; ++c) { const int ch = c * 512 + lane * 8;
                    float gb[8], uu[8], y[8];
                    unpack8(*(const u32x4*)(GBp + (size_t)m * 1024 + ch), gb); unpack8(*(const u32x4*)(GCp + (size_t)m * 1024 + ch), uu);
                    float ss = 0.f;
#pragma unroll
                    for (int j = 0; j < 8; ++j) { const float u0 = uu[j]; y[j] = gb[j] * (w0[c][j] * u2[c][j] + w1[c][j] * u1[c][j] + w2[c][j] * u0); u2[c][j] = u1[c][j]; u1[c][j] = u0; ss += y[j] * y[j]; }
                    ss = sum16(ss); const float rs = 1.0f / sqrtf(ss * (1.0f / 128.0f) + EPS);
#pragma unroll
                    for (int j = 0; j < 8; ++j) y[j] *= rs * MIXQ;
                    { u32x2 o; o.x = q8(y[0]) | (q8(y[1]) << 8) | (q8(y[2]) << 16) | (q8(y[3]) << 24); o.y = q8(y[4]) | (q8(y[5]) << 8) | (q8(y[6]) << 16) | (q8(y[7]) << 24);
                      *(u32x2*)(MIX + (size_t)m * D + ch) = o; }
                }
            }
            continue;
        }
        r -= NRUN;
        if (r < NB * NMETA) {
            const int b = r >> 4, rr = r & 15; bf16* row = Kp + (size_t)(b * TP + rr) * 1024;
#pragma unroll
            for (int c = 0; c < 2; ++c) { const int ch = c * 512 + lane * 8; float f[8]; float ss = 0.f;
#pragma unroll
                for (int j = 0; j < 8; ++j) { f[j] = MP[(size_t)rr * NPROJ + 4096 + ch + j]; ss += f[j] * f[j]; }
                ss = sum16(ss); const float rs = 1.0f / sqrtf(ss * (1.0f / DH) + EPS); const int d0 = (lane & 15) * 8;
#pragma unroll
                for (int j = 0; j < 8; ++j) f[j] = f[j] * rs * F.g_k[d0 + j];
                *(u32x4*)(Kp + k_off(b, rr, ch >> 7, ch & 127)) = pack8(f); }
            continue;
        }
        r -= NB * NMETA;
        if (r < NB * NMETA) {
            const int b = r >> 4, rr = r & 15; bf16* row = Kp + (size_t)(b * TP + TT + rr) * 1024;
            *(u32x4*)(Kp + k_off(b, TT + rr, (lane * 8) >> 7, (lane * 8) & 127)) = (u32x4){0u, 0u, 0u, 0u}; *(u32x4*)(Kp + k_off(b, TT + rr, (512 + lane * 8) >> 7, (lane * 8) & 127)) = (u32x4){0u, 0u, 0u, 0u};
            continue;
        }
        r -= NB * NMETA;
        {
            const int b = r >> 3, hh = r & 7;
#pragma unroll
            for (int dd = 0; dd < 2; ++dd) { const int d = 2 * lane + dd; bf16* col = VTp + ((size_t)(b * NH + hh) * DH + d) * TP;
                float f[8], g[8];
#pragma unroll
                for (int j = 0; j < 8; ++j) { f[j] = MP[(size_t)j * NPROJ + 5120 + hh * 128 + d]; g[j] = MP[(size_t)(8 + j) * NPROJ + 5120 + hh * 128 + d]; }
                *(u32x4*)col = pack8(f); *(u32x4*)(col + 8) = pack8(g);
                *(u32x4*)(col + TT) = (u32x4){0u, 0u, 0u, 0u}; *(u32x4*)(col + TT + 8) = (u32x4){0u, 0u, 0u, 0u}; }
        }
    }
}

DI void attn_simple(Frame& F) {
    const bf16* Qp = wsp<bf16>(F, WS_Q); const bf16* Kp = wsp<bf16>(F, WS_K); const bf16* VTp = wsp<bf16>(F, WS_VT); unsigned char* MIX = wsp<unsigned char>(F, WS_MIX);
    const int lane = F.lane;
    for (int it = F.gw; it < MR * NH; it += F.NGW) {
        const int m = it >> 3, hh = it & 7, b = m >> 11, s = m & 2047, t = NMETA + s;
        const unsigned qd = *(const unsigned*)(Qp + (size_t)m * 1024 + hh * 128 + 2 * lane);
        const bf16* v0p = VTp + ((size_t)(b * NH + hh) * DH + 2 * lane) * TP; const bf16* v1p = v0p + TP;
        float a0 = 0.f, a1 = 0.f, R = 0.f;
        for (int tk = t - 1; tk >= 0; --tk) {
            const unsigned kd = *(const unsigned*)(Kp + k_off(b, tk, hh, 2 * lane));
            const float z = wave_sum(dot2bf(qd, kd, 0.f));
            const float l2 = __builtin_amdgcn_logf(1.0f + __builtin_amdgcn_exp2f(-fabsf(z)));
            const float sp = fmaxf(z, 0.f) + l2;
            const float w = __builtin_amdgcn_exp2f((z - sp) + R);
            R -= sp;
            a0 += w * bf2f(v0p[tk]); a1 += w * bf2f(v1p[tk]);
        }
        const float ss = wave_sum(a0 * a0 + a1 * a1), rs = 1.0f / sqrtf(ss * (1.0f / DH) + EPS);
        *(unsigned short*)(MIX + (size_t)m * D + DC + hh * 128 + 2 * lane) = (unsigned short)(q8s(a0 * rs * (2.0f * MIXQ)) | (q8s(a1 * rs * (2.0f * MIXQ)) << 8));
    }
}

DI void attn_fast(Frame& F) {
    const bf16* Qp = wsp<bf16>(F, WS_Q); const bf16* Kp = wsp<bf16>(F, WS_K); const bf16* VTp = wsp<bf16>(F, WS_VT); unsigned char* MIX = wsp<unsigned char>(F, WS_MIX);
    const int lane = F.lane, qq = lane & 31, hlf = lane >> 5;
    const int pi = 16 * ((qq >> 2) & 1) + (qq & 3) + 4 * (qq >> 3);
    constexpr int NQB = 65, NTASK = NB * NH * NQB;
    for (int it = F.gw; it < NTASK; it += F.NGW) {
        const int qb = it < 64 * 64 ? 1 + (it & 63) : 0, bh = it < 64 * 64 ? (it >> 6) : it - 64 * 64, b = bh >> 3, hh = bh & 7;
        const int tq = 32 * qb + qq; const bool qvalid = (tq >= NMETA) && (tq < TT);
        int s = tq - NMETA; s = s < 0 ? 0 : (s > SEQ - 1 ? SEQ - 1 : s);
        const int m = b * SEQ + s;
        bf16x8 qf[8];
        { const bf16* qrow = Qp + (size_t)m * 1024 + hh * 128 + 8 * hlf;
#pragma unroll
          for (int ks = 0; ks < 8; ++ks) qf[ks] = *(const bf16x8*)(qrow + 16 * ks); }
        f32x16 o[4];
#pragma unroll
        for (int d = 0; d < 4; ++d)
#pragma unroll
            for (int r = 0; r < 16; ++r) o[d][r] = 0.f;
        float carry = 0.f;
        const bf16* kbase = Kp + k_off(b, pi, hh, 8 * hlf);
        const bf16* vbase = VTp + ((size_t)(b * NH + hh) * DH + qq) * TP + 16 * hlf;
        bf16x8 kf[8];
#pragma unroll
        for (int ks = 0; ks < 8; ++ks) kf[ks] = *(const bf16x8*)(kbase + (size_t)qb * 4096 + 512 * ks);
        const int thr = qq - 16 * hlf;
        bf16x8 vf[4][2];
#pragma unroll
        for (int d = 0; d < 4; ++d)
#pragma unroll
            for (int sx = 0; sx < 2; ++sx) vf[d][sx] = *(const bf16x8*)(vbase + (size_t)d * 32 * TP + qb * 32 + 8 * sx);
        for (int jt = qb; jt >= 0; --jt) {
            f32x16 st;
#pragma unroll
            for (int r = 0; r < 16; ++r) st[r] = 0.f;
#pragma unroll
            for (int ks = 0; ks < 8; ++ks) st = __builtin_amdgcn_mfma_f32_32x32x16_bf16(kf[ks], qf[ks], st, 0, 0, 0);
            { const int jn = jt > 0 ? jt - 1 : 0;
#pragma unroll
              for (int ks = 0; ks < 8; ++ks) kf[ks] = *(const bf16x8*)(kbase + (size_t)jn * 4096 + 512 * ks); }
            const bool diag = (jt == qb);
            float sp[16], lb[16]; float tot = 0.f;
#pragma unroll
            for (int r = 0; r < 16; ++r) {
                const float z = st[r];
                const float l2 = __builtin_amdgcn_logf(1.0f + __builtin_amdgcn_exp2f(-fabsf(z)));
                float spv = fmaxf(z, 0.f) + l2; lb[r] = fminf(z, 0.f) - l2;
                if (diag && !(r < thr)) spv = 0.f;
                sp[r] = spv; tot += spv;
            }
            const float tot_o = __shfl_xor(tot, 32);
            float run = carry + (hlf ? 0.f : tot_o);
            float w[16];
#pragma unroll
            for (int r = 15; r >= 0; --r) {
                float wv = __builtin_amdgcn_exp2f(lb[r] - run);
                if (diag && !(r < thr)) wv = 0.f;
                w[r] = wv; run += sp[r];
            }
            carry += tot + tot_o;
#pragma unroll
            for (int sx = 0; sx < 2; ++sx) {
                u32x4 pw; pw.x = pk2(w[8 * sx + 0], w[8 * sx + 1]); pw.y = pk2(w[8 * sx + 2], w[8 * sx + 3]); pw.z = pk2(w[8 * sx + 4], w[8 * sx + 5]); pw.w = pk2(w[8 * sx + 6], w[8 * sx + 7]);
                const bf16x8 wb = __builtin_bit_cast(bf16x8, pw);
#pragma unroll
                for (int d = 0; d < 4; ++d) o[d] = __builtin_amdgcn_mfma_f32_32x32x16_bf16(vf[d][sx], wb, o[d], 0, 0, 0);
            }
            { const int jn = jt > 0 ? jt - 1 : 0;
#pragma unroll
              for (int d = 0; d < 4; ++d)
#pragma unroll
                  for (int sx = 0; sx < 2; ++sx) vf[d][sx] = *(const bf16x8*)(vbase + (size_t)d * 32 * TP + jn * 32 + 8 * sx); }
            if (__all((!qvalid) || (carry >= ATTN_EXIT))) break;
        }
        float ss = 0.f;
#pragma unroll
        for (int d = 0; d < 4; ++d)
#pragma unroll
            for (int r = 0; r < 16; ++r) ss += o[d][r] * o[d][r];
        ss += __shfl_xor(ss, 32);
        const float rs = 1.0f / sqrtf(ss * (1.0f / DH) + EPS);
        if (qvalid) {
            unsigned char* orow = MIX + (size_t)m * D + DC + hh * 128 + 4 * hlf; const float rq = rs * (2.0f * MIXQ);
#pragma unroll
            for (int d = 0; d < 4; ++d)
#pragma unroll
                for (int g = 0; g < 4; ++g)
                    *(unsigned*)(orow + 32 * d + 8 * g) = q8s(o[d][4 * g] * rq) | (q8s(o[d][4 * g + 1] * rq) << 8) | (q8s(o[d][4 * g + 2] * rq) << 16) | (q8s(o[d][4 * g + 3] * rq) << 24);
        }
    }
}

DI void chain16(float (&L)[16], float x) {
#pragma unroll
    for (int k = 0; k < 16; ++k) { const float hi = fmaxf(L[k], x); x = fminf(L[k], x); L[k] = hi; }
}
DI void cex_desc(float& a, float& b) { const float hi = fmaxf(a, b), lo = fminf(a, b); a = hi; b = lo; }
DI void sort16_desc(float (&v)[16]) {
#pragma unroll
    for (int k = 2; k <= 16; k <<= 1)
#pragma unroll
        for (int j = k >> 1; j > 0; j >>= 1)
#pragma unroll
            for (int i = 0; i < 16; ++i) { const int l = i ^ j; if (l > i) { if ((i & k) == 0 || k == 16) cex_desc(v[i], v[l]); else cex_desc(v[l], v[i]); } }
}
DI void merge16_desc(float (&L)[16], const float (&M)[16]) {
#pragma unroll
    for (int i = 0; i < 16; ++i) L[i] = fmaxf(L[i], M[15 - i]);
#pragma unroll
    for (int j = 8; j > 0; j >>= 1)
#pragma unroll
        for (int i = 0; i < 16; ++i) if ((i & j) == 0) cex_desc(L[i], L[i + j]);
}
DI void load16(const unsigned short* sp, int c16, float (&M)[16]) {
#pragma unroll
    for (int h = 0; h < 2; ++h) { const u32x4 v = *(const u32x4*)(sp + 512 * (2 * c16 + h));
#pragma unroll
        for (int e = 0; e < 4; ++e) { const f32x2 f = unpkh2(v[e]);
            M[8 * h + 2 * e] = __uint_as_float(__float_as_uint(f.x) | (unsigned)(16 * c16 + 8 * h + 2 * e));
            M[8 * h + 2 * e + 1] = __uint_as_float(__float_as_uint(f.y) | (unsigned)(16 * c16 + 8 * h + 2 * e + 1)); } }
}
DI void scan128(const unsigned short* sp, float (&L)[16]) {
    load16(sp, 0, L); sort16_desc(L);
#pragma unroll 1
    for (int c = 1; c < 8; ++c) { float M[16]; load16(sp, c, M); sort16_desc(M); merge16_desc(L, M); }
}
template <bool OWN  >
DI void topk_fast(Frame& F) {
    const unsigned short* SC = wsp<unsigned short>(F, WS_SC); const float* SS1 = wsp<float>(F, WS_SS1); float* R1 = wsp<float>(F, WS_R1); u32x4* PAIRS = wsp<u32x4>(F, WS_PAIRS);
    LAS unsigned char* slot = F.lds + F.tid * 32;
    pg8::StaticOrder S; S.init(MR, D, F.G, (int)blockIdx.x);
    for (int gl = OWN ? F.tid : blockIdx.x * NTHREADS + F.tid; ; gl += OWN ? NTHREADS : F.G * NTHREADS) {
        int m, hh;
        if (OWN) { pg8::Unit u; if (!S.next(gl >> 8, u)) break; m = u.pm * 256 + (gl & 255); hh = u.pn; }
        else { if (gl >= MR * PEER_H) break; m = gl >> 3; hh = gl & 7; }
        float ssq = 0.f;
#pragma unroll 8
        for (int sl = 0; sl < 32; ++sl) ssq += SS1[(size_t)sl * MR + m];
        const float r1 = 1.0f / sqrtf(ssq * (1.0f / D) + EPS);
        if (hh == 0) R1[m] = r1;
        float A[16], B[16];
        { const unsigned short* lp = SC + ((size_t)((m >> 6) * 8 + hh) * 32 * 64 + (m & 63)) * 8;
          scan128(lp, A);
          scan128(lp + 16 * 512, B); }
        { u32x4 wa, wb; unsigned t[8];
#pragma unroll
          for (int q = 0; q < 4; ++q) { t[q] = (__float_as_uint(A[4 * q]) & 127u) | ((__float_as_uint(A[4 * q + 1]) & 127u) << 8) | ((__float_as_uint(A[4 * q + 2]) & 127u) << 16) | ((__float_as_uint(A[4 * q + 3]) & 127u) << 24);
                                         t[4 + q] = (__float_as_uint(B[4 * q]) & 127u) | ((__float_as_uint(B[4 * q + 1]) & 127u) << 8) | ((__float_as_uint(B[4 * q + 2]) & 127u) << 16) | ((__float_as_uint(B[4 * q + 3]) & 127u) << 24); }
          wa.x = t[0]; wa.y = t[1]; wa.z = t[2]; wa.w = t[3]; wb.x = t[4]; wb.y = t[5]; wb.z = t[6]; wb.w = t[7];
          *(LAS u32x4*)slot = wa; *(LAS u32x4*)(slot + 16) = wb; }
        float C[16];
#pragma unroll
        for (int k = 0; k < 16; ++k) C[k] = -3.0e38f;
#pragma unroll
        for (int i = 0; i < 16; ++i)
#pragma unroll
            for (int j = 0; j < 16; ++j)
                if ((i + 1) * (j + 1) <= 16) {
                    const float sum = __uint_as_float(__float_as_uint(A[i]) & ~127u) + __uint_as_float(__float_as_uint(B[j]) & ~127u);
                    chain16(C, __uint_as_float((__float_as_uint(sum) & ~255u) | (unsigned)(i * 16 + j)));
                }
        const float top = __uint_as_float(__float_as_uint(C[0]) & ~255u);
        float ex[16]; float den = 0.f; unsigned eid[16];
#pragma unroll
        for (int k = 0; k < 16; ++k) { const unsigned cb = __float_as_uint(C[k]); const unsigned code = cb & 255u;
            ex[k] = __expf((__uint_as_float(cb & ~255u) - top) * r1); den += ex[k];
            eid[k] = (unsigned)slot[code >> 4] * NKEYS + (unsigned)slot[16 + (code & 15u)]; }
        const float inv = 1.0f / den;
        u32x4* dst = PAIRS + ((size_t)m * 128 + hh * PEER_K) / 4;
#pragma unroll
        for (int k = 0; k < 16; k += 4) { dst[k / 4] = (u32x4){eid[k], eid[k + 1], eid[k + 2], eid[k + 3]};
            dst[(8 * MiB) / 16 + k / 4] = (u32x4){__float_as_uint(ex[k] * inv), __float_as_uint(ex[k + 1] * inv), __float_as_uint(ex[k + 2] * inv), __float_as_uint(ex[k + 3] * inv)}; }
    }
}

struct PdUnit { u32x4 w[16]; u32x4 xr[2]; float xs; };
DI void pd_issue(PdUnit& u, const unsigned char* ub, const bf16* xrow, const float* xsp, unsigned e0, unsigned e1, int grp) {
#pragma unroll
    for (int q = 0; q < 16; ++q) { const unsigned e = (unsigned)__shfl((int)(q < 8 ? e0 : e1), (q & 7) * 8 + grp); u.w[q] = *(const u32x4*)(ub + (size_t)e * P_RB); }
    u.xr[0] = *(const u32x4*)xrow; u.xr[1] = *(const u32x4*)((const unsigned char*)xrow + 128); u.xs = *xsp;
}
DI void pd_compute(const PdUnit& u, unsigned* pd, int sub) {
    float d[16];
#pragma unroll
    for (int q = 0; q < 16; ++q) { int ah = 0, al = 0;
#pragma unroll
        for (int c = 0; c < 4; ++c) { ah = __builtin_amdgcn_sdot8((int)u.w[q][c], (int)u.xr[0][c], ah, false); al = __builtin_amdgcn_sdot8((int)u.w[q][c], (int)u.xr[1][c], al, false); }
        d[q] = (float)(16 * ah + al) * u.xs; }
    float k8[8], k4[4], k2[2];
    const bool b4 = (sub & 4) != 0, b2 = (sub & 2) != 0, b1 = (sub & 1) != 0;
#pragma unroll
    for (int q = 0; q < 8; ++q) { const float snd = b4 ? d[q] : d[q + 8]; k8[q] = (b4 ? d[q + 8] : d[q]) + __shfl_xor(snd, 4); }
#pragma unroll
    for (int q = 0; q < 4; ++q) { const float snd = b2 ? k8[q] : k8[q + 4]; k4[q] = (b2 ? k8[q + 4] : k8[q]) + __shfl_xor(snd, 2); }
#pragma unroll
    for (int q = 0; q < 2; ++q) { const float snd = b1 ? k4[q] : k4[q + 2]; k2[q] = (b1 ? k4[q + 2] : k4[q]) + __shfl_xor(snd, 1); }
    const int i0 = (b1 ? 2 : 0) + (b2 ? 4 : 0) + (b4 ? 8 : 0);
    pd[i0 >> 1] = pk2(k2[0], k2[1]);
}
DI void peer_dots_d(Frame& F) {
    const unsigned char* U8 = wsp<unsigned char>(F, WS_UB); const bf16* H1B = wsp<bf16>(F, WS_H1B);
    const unsigned* PAIRS = wsp<unsigned>(F, WS_PAIRS); unsigned* PD = wsp<unsigned>(F, WS_PD); unsigned* ctl = wsp<unsigned>(F, WS_CTL);
    const int lane = F.lane, grp = lane >> 3, sub = lane & 7;
    const unsigned xcc = xb_xcc_id() & 7u;
    constexpr int NI = MR / 8;
#define PD_DEQ(q) ({ unsigned _v = 0u; if (lane == 0) _v = __hip_atomic_fetch_add((q), 1u, __ATOMIC_RELAXED, __HIP_MEMORY_SCOPE_AGENT); (int)_v; })
#define PD_LOADE(it, a0, a1) do { _Pragma("unroll") for (int _i = 0; _i < 8; ++_i) { a0[_i] = PAIRS[(size_t)((it) * 8 + _i) * 128 + lane]; a1[_i] = PAIRS[(size_t)((it) * 8 + _i) * 128 + 64 + lane]; } } while (0)
    for (int k = 0; k < P_NSL; ++k) {
        const int sl = (int)((xcc * (P_NSL / 8) + k) & (P_NSL - 1));
        unsigned* q = ctl + CW_Q + sl * 64;
        int cur = __builtin_amdgcn_readfirstlane(PD_DEQ(q));
        if (cur >= NI) continue;
        int nxt = __builtin_amdgcn_readfirstlane(PD_DEQ(q));
        unsigned e0[8], e1[8];
        PD_LOADE(cur, e0, e1);
        const unsigned char* ub = U8 + sl * 128 + sub * 16;
        for (;;) {
            const int nn_raw = PD_DEQ(q);
            const bool hn = nxt < NI;
            const int m0 = cur * 8;
            const bf16* xr = (const bf16*)(wsp<unsigned char>(F, WS_XQ) + (size_t)m0 * 2048 + sl * 256 + sub * 16); const float* xsp = wsp<float>(F, WS_XSC) + (size_t)m0 * 8 + sl;
            constexpr int XSTEP = 1024  , XSS = 8;
            unsigned* pd = PD + ((size_t)m0 * P_NSL + sl) * 64 + grp * 8;
            PdUnit A, B;
            pd_issue(A, ub, xr, xsp, e0[0], e1[0], grp);
#pragma unroll
            for (int i = 0; i < 8; i += 2) {
                pd_issue(B, ub, xr + (size_t)(i + 1) * XSTEP, xsp + (i + 1) * XSS, e0[i + 1], e1[i + 1], grp);
                pd_compute(A, pd + (size_t)i * (P_NSL * 64), sub);
                if (i + 2 < 8) pd_issue(A, ub, xr + (size_t)(i + 2) * XSTEP, xsp + (i + 2) * XSS, e0[i + 2], e1[i + 2], grp);
                pd_compute(B, pd + (size_t)(i + 1) * (P_NSL * 64), sub);
            }
            if (!hn) break;
            cur = nxt; nxt = __builtin_amdgcn_readfirstlane(nn_raw);
            PD_LOADE(cur, e0, e1);
        }
    }
#undef PD_DEQ
#undef PD_LOADE
}
DI void peer_reduce(Frame& F) {
    const unsigned* PD = wsp<unsigned>(F, WS_PD); const float* R1 = wsp<float>(F, WS_R1); const unsigned* PAIRS = wsp<unsigned>(F, WS_PAIRS); unsigned* PAT = wsp<unsigned>(F, WS_PAT);
    const int lane = F.lane;
    for (int m = F.gw; m < MR; m += F.NGW) {
        const u32x2 p0 = {PAIRS[(size_t)m * 128 + lane], PAIRS[(8 * MiB) / 4 + (size_t)m * 128 + lane]}, p1 = {PAIRS[(size_t)m * 128 + 64 + lane], PAIRS[(8 * MiB) / 4 + (size_t)m * 128 + 64 + lane]};
        float s0 = 0.f, s1 = 0.f;
#pragma unroll
        for (int sl = 0; sl < P_NSL; ++sl) {
            const int h = (lane & 7) * 16 + (lane >> 3); const unsigned w0 = PD[((size_t)m * P_NSL + sl) * 64 + (h >> 1)], w1 = PD[((size_t)m * P_NSL + sl) * 64 + ((h + 8) >> 1)];
            s0 += (h & 1) ? hi_f(w0) : lo_f(w0); s1 += (h & 1) ? hi_f(w1) : lo_f(w1); }
        const float r1 = R1[m]; const f32x2* SUV = wsp<f32x2>(F, WS_SU); const f32x2 t0 = SUV[p0.x], t1 = SUV[p1.x];
        const float z0 = s0 * r1 * t0.x, z1 = s1 * r1 * t1.x;
        const float a0 = __uint_as_float(p0.y) * t0.y * 0.5f * z0 * (1.0f + erff(z0 * 0.70710678118654752f));
        const float a1 = __uint_as_float(p1.y) * t1.y * 0.5f * z1 * (1.0f + erff(z1 * 0.70710678118654752f));
        float amax = fmaxf(fabsf(a0), fabsf(a1));
#pragma unroll
        for (int o = 1; o < 64; o <<= 1) amax = fmaxf(amax, __shfl_xor(amax, o));
        unsigned ex = (__float_as_uint(amax) >> 23) & 255u; ex = ex < 40u ? 40u : (ex > 200u ? 200u : ex);
        const float s = __uint_as_float((267u - ex) << 23), sinv24 = __uint_as_float((ex + 11u) << 23);
        const _Float16 h0 = (_Float16)(a0 * s), h1 = (_Float16)(a1 * s);
        const float ssum = wave_sum((float)h0 + (float)h1);
        PAT[(size_t)m * 128 + lane] = ((unsigned)__builtin_bit_cast(unsigned short, h0) << 16) | p0.x;
        PAT[(size_t)m * 128 + 64 + lane] = ((unsigned)__builtin_bit_cast(unsigned short, h1) << 16) | p1.x;
        if (lane == 0) *(f32x2*)(wsp<float>(F, WS_TS) + (size_t)m * 2) = (f32x2){sinv24, -8.0f * ssum * sinv24 * (1.0f / 16777216.0f)};
    }
}
struct PoUnit { u32x4 w[16]; unsigned ap[8]; };
DI void po_issue(PoUnit& u, const unsigned char* vb, unsigned w0, unsigned w1, int grp) {
#pragma unroll
    for (int q = 0; q < 16; ++q) { const unsigned wd = (unsigned)__shfl((int)(q < 8 ? w0 : w1), (q & 7) * 8 + grp); u.w[q] = *(const u32x4*)(vb + (size_t)(wd & 0xffffu) * P_RB);
        if (q & 1) u.ap[q >> 1] |= (wd & 0xffff0000u); else u.ap[q >> 1] = wd >> 16; }
}
DI void po_step(PoUnit& u, unsigned l0, unsigned l1, unsigned lmask, const unsigned char* vb, int grp, float* orow, const bf16* hrow, const float* tsp, int lane) {
    const bool b32 = (lane & 32) != 0, b16 = (lane & 16) != 0, b8 = (lane & 8) != 0;
    const int col = 32 * (lane & 7) + (b32 ? 16 : 0) + (b16 ? 8 : 0) + (b8 ? 4 : 0);
    const f32x2 ts = *(const f32x2*)tsp; const u32x2 hb = *(const u32x2*)(hrow + col);
    __builtin_amdgcn_sched_barrier(0);
    h16x2 acc[16];
#pragma unroll
    for (int i = 0; i < 16; ++i) acc[i] = (h16x2){(_Float16)0.f, (_Float16)0.f};
#pragma unroll
    for (int qp = 0; qp < 8; ++qp) {
#pragma unroll
        for (int h = 0; h < 2; ++h) { const int q = 2 * qp + h;
            const h16x2 a2 = __builtin_bit_cast(h16x2, __builtin_amdgcn_perm(u.ap[qp], u.ap[qp], h ? 0x03020302u : 0x01000100u));
#pragma unroll
            for (int c = 0; c < 4; ++c) { const unsigned wd = u.w[q][c], w8 = wd >> 8;
                acc[4 * c] += a2 * __builtin_bit_cast(h16x2, wd & 0x000f000fu); acc[4 * c + 1] += a2 * __builtin_bit_cast(h16x2, wd & 0x00f000f0u);
                acc[4 * c + 2] += a2 * __builtin_bit_cast(h16x2, w8 & 0x000f000fu); acc[4 * c + 3] += a2 * __builtin_bit_cast(h16x2, w8 & 0x00f000f0u); } }
        { const unsigned wa = (unsigned)__shfl((int)(qp < 4 ? l0 : l1), ((2 * qp) & 7) * 8 + grp) & lmask, wb = (unsigned)__shfl((int)(qp < 4 ? l0 : l1), ((2 * qp + 1) & 7) * 8 + grp) & lmask;
          u.w[2 * qp] = *(const u32x4*)(vb + (size_t)(wa & 0xffffu) * P_RB); u.w[2 * qp + 1] = *(const u32x4*)(vb + (size_t)(wb & 0xffffu) * P_RB);
          u.ap[qp] = (wa >> 16) | (wb & 0xffff0000u); }
    }
    h16x2 k8[8], k4[4], k2[2];
#define PO_XCH(v, m) __builtin_bit_cast(h16x2, (unsigned)__shfl_xor((int)__builtin_bit_cast(unsigned, (v)), (m)))
#pragma unroll
    for (int i = 0; i < 8; ++i) { const h16x2 snd = b32 ? acc[i] : acc[i + 8]; k8[i] = (b32 ? acc[i + 8] : acc[i]) + PO_XCH(snd, 32); }
#pragma unroll
    for (int i = 0; i < 4; ++i) { const h16x2 snd = b16 ? k8[i] : k8[i + 4]; k4[i] = (b16 ? k8[i + 4] : k8[i]) + PO_XCH(snd, 16); }
#pragma unroll
    for (int i = 0; i < 2; ++i) { const h16x2 snd = b8 ? k4[i] : k4[i + 2]; k2[i] = (b8 ? k4[i + 2] : k4[i]) + PO_XCH(snd, 8); }
#undef PO_XCH
    const float c0 = ts.x, c0b = ts.x * 0.0625f, c1 = ts.y;
    const f32x4 ov = (f32x4){lo_f(hb.x) + ((float)k2[0].x * c0 + c1), hi_f(hb.x) + ((float)k2[0].y * c0 + c1), lo_f(hb.y) + ((float)k2[1].x * c0b + c1), hi_f(hb.y) + ((float)k2[1].y * c0b + c1)};
    __builtin_nontemporal_store(ov, (f32x4*)(orow + col));
}
DI void peer_out_d(Frame& F) {
    const unsigned char* V8 = wsp<unsigned char>(F, WS_VB); const bf16* H1B = wsp<bf16>(F, WS_H1B); const unsigned* PAT = wsp<unsigned>(F, WS_PAT); unsigned* ctl = wsp<unsigned>(F, WS_CTL);
    const int lane = F.lane, grp = lane >> 3, sub = lane & 7;
    const unsigned xcc = xb_xcc_id() & 7u;
    constexpr int NI = MR / 8;
#define PO_DEQ(q) ({ unsigned _v = 0u; if (lane == 0) _v = __hip_atomic_fetch_add((q), 1u, __ATOMIC_RELAXED, __HIP_MEMORY_SCOPE_AGENT); (int)_v; })
#define PO_TOK(j) ((j) < 8 ? cur * 8 + (j) : (nxt * 8 + (j) - 8 < MR ? nxt * 8 + (j) - 8 : MR - 1))
    for (int k = 0; k < P_NSL; ++k) {
        const int sl = (int)((xcc * (P_NSL / 8) + k) & (P_NSL - 1));
        unsigned* q = ctl + CW_Q + (16 + sl) * 64;
        int cur = __builtin_amdgcn_readfirstlane(PO_DEQ(q));
        if (cur >= NI) continue;
        int nxt = __builtin_amdgcn_readfirstlane(PO_DEQ(q));
        const unsigned char* vb = V8 + sl * 128 + sub * 16;
        PoUnit A, B;
        unsigned la0, la1, lb0, lb1;
        { const int t0 = PO_TOK(0), t1 = PO_TOK(1), t2 = PO_TOK(2), t3 = PO_TOK(3);
          const unsigned x0 = PAT[(size_t)t0 * 128 + lane], y0 = PAT[(size_t)t0 * 128 + 64 + lane], x1 = PAT[(size_t)t1 * 128 + lane], y1 = PAT[(size_t)t1 * 128 + 64 + lane];
          la0 = PAT[(size_t)t2 * 128 + lane]; la1 = PAT[(size_t)t2 * 128 + 64 + lane]; lb0 = PAT[(size_t)t3 * 128 + lane]; lb1 = PAT[(size_t)t3 * 128 + 64 + lane];
          po_issue(A, vb, x0, y0, grp); po_issue(B, vb, x1, y1, grp); }
        for (;;) {
            const int nn_raw = PO_DEQ(q);
            const bool hn = nxt < NI;
            const int m0 = cur * 8;
            float* orow = F.out + (size_t)m0 * D + sl * P_COLS; const bf16* hrow = H1B + (size_t)m0 * D + sl * P_COLS; const float* tsp = wsp<float>(F, WS_TS) + (size_t)m0 * 2;
#pragma unroll
            for (int i = 0; i < 8; ++i) {
                const int t4 = PO_TOK(i + 4);
                const unsigned lc0 = PAT[(size_t)t4 * 128 + lane], lc1 = PAT[(size_t)t4 * 128 + 64 + lane];
                const unsigned lmask = (i + 2 < 8 || hn) ? 0xffffffffu : 0u;
                po_step((i & 1) ? B : A, la0, la1, lmask, vb, grp, orow + (size_t)i * D, hrow + (size_t)i * D, tsp + 2 * i, lane);
                la0 = lb0; la1 = lb1; lb0 = lc0; lb1 = lc1;
            }
            if (!hn) break;
            cur = nxt; nxt = __builtin_amdgcn_readfirstlane(nn_raw);
        }
    }
#undef PO_DEQ
#undef PO_TOK
}
constexpr int NPHASE = 9;
__global__ void __launch_bounds__(NTHREADS, 2) mk_fwd(Args args) {
    extern __shared__ __attribute__((aligned(16))) unsigned char lds_raw[];
    Frame F;
    F.lds = (LAS unsigned char*)lds_raw;
    F.tid = threadIdx.x; F.lane = F.tid & 63; F.wave = __builtin_amdgcn_readfirstlane(F.tid >> 6);
    F.G = gridDim.x; F.gw = blockIdx.x * NWAVES + F.wave; F.NGW = F.G * NWAVES;
    F.x = args.in[0]; F.meta = args.in[1]; F.g_mix = args.in[2]; F.w_in = args.in[3]; F.conv_w = args.in[4]; F.g_q = args.in[5]; F.g_k = args.in[6]; F.g_out = args.in[7];
    F.w_out = args.in[8]; F.g_ffn = args.in[9]; F.w_query = args.in[10]; F.sub_keys = args.in[11]; F.eu = args.in[12]; F.ev = args.in[13];
    F.out = args.out; F.ws = args.ws;
    volatile LAS unsigned* MISC = (volatile LAS unsigned*)(F.lds + LDSCTL_OFF);
    for (int u = F.tid; u < (LDS_BYTES - LDSCTL_OFF) / 4; u += NTHREADS) ((LAS unsigned*)(F.lds + LDSCTL_OFF))[u] = 0u;
    __syncthreads();
    const int lo = args.ph_lo, hi = args.ph_hi;
    XcdBarrier bar; bar.bar = wsp<unsigned>(F, WS_CTL) + CW_BAR; bar.x = 0; bar.st = nullptr;
    if (hi - lo > 1) bar = xcd_barrier_post(wsp<unsigned>(F, WS_CTL) + CW_BAR, MISC + 8);
#ifndef REPEAT_MASK
#define REPEAT_MASK 0
#endif
#define IN(k) (lo <= (k) && (k) < hi)
#define REP(k) (((REPEAT_MASK) >> (k)) & 1 ? 2 : 1)
#define SEAM(k) do { if (IN(k) && IN((k) + 1)) xcd_barrier(bar); } while (0)

    if (IN(0)) { for (int rep = 0; rep < REP(0); ++rep) p0_prep(F); } SEAM(0);
    if (IN(1)) for (int rep = 0; rep < REP(1); ++rep) {
        p2_norm_conv<1>(F);
        __syncthreads();
        pg8::Gemm g{wsp<bf16>(F, WS_XB), wsp<bf16>(F, WS_W1T), MR, NPROJ, D / 2}; pg8::StaticOrder S; S.init(MR, NPROJ, F.G, (int)blockIdx.x);
        EpiG1 E{wsp<float>(F, WS_R0), wsp<bf16>(F, WS_GB), wsp<bf16>(F, WS_GC), wsp<bf16>(F, WS_CI), wsp<bf16>(F, WS_Q), wsp<bf16>(F, WS_K), wsp<bf16>(F, WS_VT), F.g_q, F.g_k, (LAS float*)(F.lds + LDSCTL_OFF + 1024), (const unsigned*)(F.ws + WS_CTL + CB_CM)};
        pg8::gemm_phase<EpiG1, pg8::StaticOrder, true, true, false, true>(F.lds, g, S, E);

    } SEAM(1);
#if FAST_ATTN
    if (IN(3)) {
        for (int step = 0; step < 2; ++step) {
            if ((step == 0) == (F.wave >= 4)) { for (int rep = 0; rep < REP(10); ++rep) p2_norm_conv<0>(F); }
            else for (int rep = 0; rep < REP(3); ++rep) attn_fast(F);
        }
        for (int rep = 0; rep < REP(11); ++rep) table_rows(F, 4);
    } SEAM(3);
#else
    if (IN(3)) { attn_simple(F); } SEAM(3);
#endif
    if (IN(4)) for (int rep = 0; rep < REP(4); ++rep) {
        pg8::Gemm g{wsp<bf16>(F, WS_MIX), wsp<bf16>(F, WS_WOT), MR, D, D / 2}; pg8::StaticOrder S; S.init(MR, D, F.G, (int)blockIdx.x);
        EpiG2 E{wsp<unsigned char>(F, WS_XB), wsp<float>(F, WS_SX), wsp<bf16>(F, WS_H1B), wsp<float>(F, WS_SS1), wsp<unsigned char>(F, WS_H1F8), (const unsigned*)(F.ws + WS_CTL + CB_CM2)};
        pg8::gemm_phase<EpiG2, pg8::StaticOrder, true, true, false, true>(F.lds, g, S, E);
    } SEAM(4);
    if (IN(5)) for (int rep = 0; rep < REP(5); ++rep) {
#if G3_FP8
        pg8::Gemm g{wsp<bf16>(F, WS_H1F8), wsp<bf16>(F, WS_W2T), MR, D, D / 2}; pg8::StaticOrder S; S.init(MR, D, F.G, (int)blockIdx.x);
        EpiG3 E{wsp<unsigned short>(F, WS_SC)};
        pg8::gemm_phase<EpiG3, pg8::StaticOrder, true, true, true>(F.lds, g, S, E);
#else
        pg8::Gemm g{wsp<bf16>(F, WS_H1B), wsp<bf16>(F, WS_W2T), MR, D, D}; pg8::StaticOrder S; S.init(MR, D, F.G, (int)blockIdx.x);
        EpiG3 E{wsp<unsigned short>(F, WS_SC)};
        pg8::gemm_phase<EpiG3, pg8::StaticOrder, true, true>(F.lds, g, S, E);
#endif
    }
    if (IN(5)) { asm volatile("s_waitcnt vmcnt(0)" ::: "memory"); __syncthreads(); }
    if (IN(6)) {
        for (int step = 0; step < 2; ++step) {
            if ((step == 0) == (F.wave >= 4)) { for (int rep = 0; rep < REP(12); ++rep) table_rows(F, 2);
                for (int rep = 0; rep < REP(13); ++rep) table_rows(F, 6);
            }
            else for (int rep = 0; rep < REP(6); ++rep) topk_fast<true>(F);
        }
    } SEAM(6);
    if (IN(7)) { for (int rep = 0; rep < REP(7); ++rep) { if (rep) { xcd_barrier(bar); if (blockIdx.x == 0 && F.tid < 16) __hip_atomic_store(wsp<unsigned>(F, WS_CTL) + CW_Q + F.tid * 64, 0u, __ATOMIC_RELAXED, __HIP_MEMORY_SCOPE_AGENT); xcd_barrier(bar); } peer_dots_d(F); } xcd_barrier(bar); for (int rep = 0; rep < REP(9); ++rep) peer_reduce(F); } SEAM(7);
    if (IN(8)) { for (int rep = 0; rep < REP(8); ++rep) { if (rep) { xcd_barrier(bar); if (blockIdx.x == 0 && F.tid < 16) __hip_atomic_store(wsp<unsigned>(F, WS_CTL) + CW_Q + (16 + F.tid) * 64, 0u, __ATOMIC_RELAXED, __HIP_MEMORY_SCOPE_AGENT); xcd_barrier(bar); } peer_out_d(F); } }
#undef IN
#undef SEAM
}

extern "C" void kernel_launch(void* const* d_in, const int* in_sizes, int n_in, void* d_out, int out_size, void* d_ws, size_t ws_size, hipStream_t stream) {
    static int grid = 0;
    if (grid == 0) {
        if (n_in != 14 || in_sizes[0] != MR * D || out_size != MR * D || ws_size < WS_END) {
            fprintf(stderr, "kernel_launch: unexpected shapes: n_in %d in0 %d out %d ws %zu (need %zu)\n", n_in, n_in > 0 ? in_sizes[0] : -1, out_size, ws_size, (size_t)WS_END); grid = -1; return; }
        int dev = 0, cus = 0;
        if (hipGetDevice(&dev) != hipSuccess || hipDeviceGetAttribute(&cus, hipDeviceAttributeMultiprocessorCount, dev) != hipSuccess) { grid = -1; return; }
        if (hipFuncSetAttribute((const void*)mk_fwd, hipFuncAttributeMaxDynamicSharedMemorySize, LDS_BYTES) != hipSuccess) { fprintf(stderr, "kernel_launch: hipFuncSetAttribute failed\n"); grid = -1; return; }
        (void)hipGetLastError();
        grid = cus;
    }
    if (grid < 0) return;
    (void)hipMemsetAsync((char*)d_ws + WS_CTL, 0, CTL_ZERO_BYTES, stream);
    Args a{};
    for (int i = 0; i < 14; ++i) a.in[i] = (const float*)d_in[i];
    a.out = (float*)d_out; a.ws = (unsigned char*)d_ws;
#if N_LAUNCH_PER_PHASE
    for (int p = 0; p < NPHASE; ++p) { a.ph_lo = p; a.ph_hi = p + 1; hipLaunchKernelGGL(mk_fwd, dim3(grid), dim3(NTHREADS), LDS_BYTES, stream, a); }
#else
    a.ph_lo = 0; a.ph_hi = NPHASE; hipLaunchKernelGGL(mk_fwd, dim3(grid), dim3(NTHREADS), LDS_BYTES, stream, a);
#endif
}
```

```cpp
#include <hip/hip_runtime.h>
#include <cstdio>
#include <cstdint>

#define DI __device__ __forceinline__
#define LAS __attribute__((address_space(3)))
#define GAS __attribute__((address_space(1)))

#ifndef N_LAUNCH_PER_PHASE
#define N_LAUNCH_PER_PHASE 0
#endif
#ifndef FAST_ATTN
#define FAST_ATTN 1
#endif
#define G3_FP8 0

constexpr int NB = 8, SEQ = 2048, NMETA = 16, TT = SEQ + NMETA  , TP = 2080  ;
constexpr int D = 2048, MR = NB * SEQ  ;
constexpr int DC = 1024, DA = 1024, NH = 8, DH = 128, NPROJ = 6144;
constexpr int PEER_H = 8, PEER_K = 16, NKEYS = 128, NEXP = 16384;
constexpr float EPS = 1e-6f;
constexpr int P_NSL = 8;
constexpr int P_COLS = D / P_NSL;
constexpr int P_RB = 128;
constexpr size_t P_SLB = (size_t)NEXP * 128;
constexpr float ATTN_EXIT = 64.0f;
constexpr float QSCALE = 0.08838834764831845f * 1.4426950408889634f;

typedef unsigned short bf16;
typedef float f32x4 __attribute__((ext_vector_type(4)));
typedef float f32x2 __attribute__((ext_vector_type(2)));
typedef unsigned u32x4 __attribute__((ext_vector_type(4)));
typedef unsigned u32x2 __attribute__((ext_vector_type(2)));
typedef int i32x4 __attribute__((ext_vector_type(4)));
typedef int i32x8 __attribute__((ext_vector_type(8)));
typedef short bf16x8 __attribute__((ext_vector_type(8)));
typedef float f32x16 __attribute__((ext_vector_type(16)));
typedef __attribute__((ext_vector_type(2))) __bf16 bf2_t;
typedef _Float16 h16x2 __attribute__((ext_vector_type(2)));
DI unsigned pkh2(float lo, float hi) { f32x2 v = {lo, hi}; h16x2 r = __builtin_convertvector(v, h16x2); return __builtin_bit_cast(unsigned, r); }
DI f32x2 unpkh2(unsigned u) { return __builtin_convertvector(__builtin_bit_cast(h16x2, u), f32x2); }

DI unsigned pk2(float lo, float hi) { f32x2 v = {lo, hi}; bf2_t r = __builtin_convertvector(v, bf2_t); return __builtin_bit_cast(unsigned, r); }
DI bf16 f2bf(float f) { return (bf16)(pk2(f, 0.f) & 0xffffu); }
DI float bf2f(bf16 v) { return __uint_as_float(((unsigned)v) << 16); }
DI float lo_f(unsigned u) { return __uint_as_float(u << 16); }
DI float hi_f(unsigned u) { return __uint_as_float(u & 0xffff0000u); }
DI float wave_sum(float v) {
#pragma unroll
    for (int o = 1; o < 64; o <<= 1) v += __shfl_xor(v, o);
    return v;
}
DI float dot2bf(unsigned a, unsigned b, float acc) { return __builtin_amdgcn_fdot2_f32_bf16(__builtin_bit_cast(bf2_t, a), __builtin_bit_cast(bf2_t, b), acc, false); }

constexpr size_t MiB = 1u << 20;
constexpr size_t WS_CTL = 0, CTL_ZERO_BYTES = 1 * MiB;
constexpr size_t WS_W1T = 1 * MiB;
constexpr size_t WS_WOT = 25 * MiB;
constexpr size_t WS_W2T = 33 * MiB;
constexpr size_t WS_UB = 41 * MiB;
constexpr size_t WS_VB = 73 * MiB;
constexpr size_t WS_MISC = 169 * MiB;
constexpr size_t WS_R0 = WS_MISC, WS_R1 = WS_MISC + 65536, WS_METAB = WS_MISC + 2 * 65536, WS_R0M = WS_MISC + 3 * 65536, WS_METAP = WS_MISC + 4 * 65536  ;
constexpr size_t WS_SS1 = WS_MISC + 1 * MiB;
constexpr size_t WS_SU = WS_MISC + 3 * MiB;
constexpr size_t WS_XSC = WS_MISC + 3 * MiB + 262144;
constexpr size_t WS_SX = WS_MISC + 3 * MiB + 917504;
constexpr size_t WS_TS = WS_MISC + 3 * MiB + 786432;
constexpr size_t WS_XQ = 237 * MiB;
constexpr size_t WS_GB = 173 * MiB, WS_GC = 205 * MiB, WS_CI = 237 * MiB, WS_Q = 269 * MiB;
constexpr size_t WS_H1F8 = 269 * MiB;
constexpr size_t WS_SC = 173 * MiB;
constexpr size_t WS_K = 301 * MiB;
constexpr size_t WS_VT = 334 * MiB;
constexpr size_t WS_H1B = 301 * MiB;
constexpr size_t WS_XB = 367 * MiB;
constexpr size_t WS_MIX = 105 * MiB;
constexpr size_t WS_PAIRS = 431 * MiB;
constexpr size_t WS_PAT = 447 * MiB;
constexpr size_t WS_PD = 173 * MiB;
constexpr size_t WS_END = 455 * MiB;
constexpr int CW_BAR = 4096;
constexpr float MIXQ = 11.2252956f;
constexpr size_t CB_CM2 = 131072 + 32768;
constexpr size_t CB_CM = 131072;
constexpr int CW_Q = 8192;

namespace pg8 {
#define PG8_LAS __attribute__((address_space(3)))
typedef unsigned short bf16_t;
constexpr int BM = 256, BK = 64, HALF = 128, HTB = HALF * BK * 2  , STAGE_BYTES = 8 * HTB, NXCD = 8, WGM = 8;

__host__ __device__ __forceinline__ int lds_byte(int r, int c) { const int st = (r >> 4) * 2 + (c >> 5), rr = r & 15, cc = c & 31, ob = rr * 64 + cc * 2; return st * 1024 + (ob ^ (((ob >> 9) & 1) << 5)); }
__host__ __device__ __forceinline__ void stage_rc(int b, int& R, int& C) { const int st = b / 1024, sb = b % 1024, swz = sb ^ (((sb >> 9) & 1) << 5); R = (st >> 1) * 16 + swz / 64; C = (st & 1) * 32 + (swz % 64) / 2; }
__host__ __device__ __forceinline__ int perm32(int rho) { const int n = rho >> 4, i = rho & 15; return 8 * (i >> 2) + 4 * n + (i & 3); }

struct Unit { int pm, pn; };
struct Gemm { const bf16_t* A; const bf16_t* Bt; int M, N, K; };

struct StaticOrder {
    int nM, nN, nwg, G, c;
    __host__ __device__ void init(int M, int N, int G_, int c_) { nM = M / BM; nN = N / BM; nwg = nM * nN; G = G_; c = c_; }
    __host__ __device__ bool next(int i, Unit& u) const {
        const long L = (long)i * G + c; if (L >= nwg) return false;
        int wgid = (int)L; { const int q = nwg / NXCD, r = nwg % NXCD, xcd = wgid % NXCD, off = wgid / NXCD; wgid = (xcd < r ? xcd * (q + 1) : r * (q + 1) + (xcd - r) * q) + off; }
        const int nig = WGM * nN, gid = wgid / nig, fm = gid * WGM, gsz = (nM - fm) < WGM ? (nM - fm) : WGM;
        u.pm = fm + ((wgid % nig) % gsz); u.pn = (wgid % nig) / gsz; return true;
    }
    __device__ __forceinline__ void a_ready(const Unit&) const {}
    __device__ __forceinline__ void done(const Unit&) const {}
};

template <class Epi, class Sched, bool ALIGN_EPI = false, bool SP2 = false, bool FP8 = false, bool I8 = false>
__device__ __forceinline__ void gemm_phase(PG8_LAS unsigned char* lds, const Gemm g, const Sched& S, const Epi& E) {
    const int tid = threadIdx.x, wid = __builtin_amdgcn_readfirstlane(tid >> 6), lane = tid & 63, wr = wid >> 2, wc = wid & 3, fr = lane & 15, fq = lane >> 4;
    const int K = g.K, nt = K / BK;
    unsigned voffA[2], voffB[2];
#pragma unroll
    for (int i = 0; i < 2; ++i) { int R, C; stage_rc(tid * 16 + i * 8192, R, C); const int Rb = Epi::PERM ? ((R & ~31) + perm32(R & 31)) : R;
        voffA[i] = (unsigned)(R * K + C) * 2u; voffB[i] = (unsigned)(Rb * K + C) * 2u; }
    const size_t kstep = (size_t)(BK * 2);
    const size_t hstep = (size_t)HALF * K * 2;
    const size_t tstep = 2 * hstep;
    const unsigned ldsw = (unsigned)wid * 1024u;
    const int aoff = lds_byte(wr * 64 + fr, fq * 8), boff = lds_byte(wc * 32 + fr, fq * 8);
#define PG8_SA(b, h) (((b) * 2 + (h)) * HTB)
#define PG8_SB(b, h) ((4 + (b) * 2 + (h)) * HTB)
#define PG8_STAGE(bufoff, gbase, voff) do { _Pragma("unroll") for (int _i = 0; _i < 2; ++_i) \
        __builtin_amdgcn_global_load_lds((const unsigned*)((const char*)(gbase) + (voff)[_i]), (PG8_LAS unsigned*)(lds + (bufoff) + ldsw + _i * 8192), 16, 0, 0); } while (0)
#define PG8_LDA(dst, b, h) do { _Pragma("unroll") for (int m = 0; m < 4; ++m) { dst[m].lo = *(const PG8_LAS i32x4*)(lds + PG8_SA(b, h) + aoff + m * 2048); dst[m].hi = *(const PG8_LAS i32x4*)(lds + PG8_SA(b, h) + aoff + m * 2048 + 1024); } } while (0)
#define PG8_LDB(dst, b, h) do { _Pragma("unroll") for (int n = 0; n < 2; ++n) { dst[n].lo = *(const PG8_LAS i32x4*)(lds + PG8_SB(b, h) + boff + n * 2048); dst[n].hi = *(const PG8_LAS i32x4*)(lds + PG8_SB(b, h) + boff + n * 2048 + 1024); } } while (0)
#define PG8_MMA(ai, bj, At, Bt) do { __builtin_amdgcn_s_setprio(1); _Pragma("unroll") for (int m = 0; m < 4; ++m) _Pragma("unroll") for (int n = 0; n < 2; ++n) { \
        if constexpr (FP8) asm volatile("v_mfma_f32_16x16x128_f8f6f4 %0, %1, %2, %0" : "+v"(acc[ai][bj][m][n]) : "v"(Bt[n]), "v"(At[m])); \
        else if constexpr (I8) { acc[ai][bj][m][n] = __builtin_bit_cast(f32x4, __builtin_amdgcn_mfma_i32_16x16x64_i8((i32x4)Bt[n].lo, (i32x4)At[m].lo, __builtin_bit_cast(i32x4, acc[ai][bj][m][n]), 0, 0, 0)); \
               acc[ai][bj][m][n] = __builtin_bit_cast(f32x4, __builtin_amdgcn_mfma_i32_16x16x64_i8((i32x4)Bt[n].hi, (i32x4)At[m].hi, __builtin_bit_cast(i32x4, acc[ai][bj][m][n]), 0, 0, 0)); } \
        else { acc[ai][bj][m][n] = __builtin_amdgcn_mfma_f32_16x16x32_bf16(__builtin_bit_cast(bf16x8, (i32x4)Bt[n].lo), __builtin_bit_cast(bf16x8, (i32x4)At[m].lo), acc[ai][bj][m][n], 0, 0, 0); \
               acc[ai][bj][m][n] = __builtin_amdgcn_mfma_f32_16x16x32_bf16(__builtin_bit_cast(bf16x8, (i32x4)Bt[n].hi), __builtin_bit_cast(bf16x8, (i32x4)At[m].hi), acc[ai][bj][m][n], 0, 0, 0); } } __builtin_amdgcn_s_setprio(0); } while (0)
#define PG8_WAIT_V(n) asm volatile("s_waitcnt vmcnt(" #n ")" ::: "memory")
#define PG8_WAIT_L(n) asm volatile("s_waitcnt lgkmcnt(" #n ")" ::: "memory")
#define PG8_BAR __builtin_amdgcn_s_barrier()
#define PG8_SCHED __builtin_amdgcn_sched_barrier(0)
    Unit cur, nxt; int ui = 0;
    if (!S.next(0, cur)) return;
    f32x4 acc[2][2][4][2];
#pragma unroll
    for (int a = 0; a < 2; ++a)
#pragma unroll
        for (int b = 0; b < 2; ++b)
#pragma unroll
            for (int m = 0; m < 4; ++m)
#pragma unroll
                for (int n = 0; n < 2; ++n) acc[a][b][m][n] = (f32x4){0.f, 0.f, 0.f, 0.f};
    i32x8 At[4], B0[2], B1[2];
    const char* cA = (const char*)g.A + (size_t)cur.pm * tstep; const char* cB = (const char*)g.Bt + (size_t)cur.pn * tstep;
    S.a_ready(cur);
    if constexpr (SP2) {
        PG8_STAGE(PG8_SB(0, 0), cB, voffB); PG8_STAGE(PG8_SB(0, 1), cB + hstep, voffB); PG8_STAGE(PG8_SA(0, 0), cA, voffA); PG8_STAGE(PG8_SA(0, 1), cA + hstep, voffA);
        if (wr == 1) PG8_BAR;
        PG8_WAIT_V(2); PG8_BAR;
        PG8_STAGE(PG8_SB(1, 0), cB + kstep, voffB); PG8_STAGE(PG8_SA(1, 0), cA + kstep, voffA); PG8_STAGE(PG8_SB(1, 1), cB + hstep + kstep, voffB);
        PG8_WAIT_V(6); PG8_BAR;
    } else {
        PG8_STAGE(PG8_SB(0, 0), cB, voffB); PG8_STAGE(PG8_SA(0, 0), cA, voffA); PG8_STAGE(PG8_SB(0, 1), cB + hstep, voffB); PG8_STAGE(PG8_SA(0, 1), cA + hstep, voffA);
        if (wr == 1) PG8_BAR;
        PG8_WAIT_V(4); PG8_BAR;
        PG8_STAGE(PG8_SB(1, 0), cB + kstep, voffB); PG8_STAGE(PG8_SA(1, 0), cA + kstep, voffA); PG8_STAGE(PG8_SB(1, 1), cB + hstep + kstep, voffB);
        PG8_WAIT_V(6); PG8_BAR;
    }
    for (;;) {
        const bool has_next = S.next(ui + 1, nxt);
        const char* nA = has_next ? (const char*)g.A + (size_t)nxt.pm * tstep : cA; const char* nB = has_next ? (const char*)g.Bt + (size_t)nxt.pn * tstep : cB;
        for (int t = 0; t < nt; t += 2) {
            const bool last = (t == nt - 2);
            const char* a1 = cA + (size_t)(t + 1) * kstep;
            const char* a2 = last ? nA : cA + (size_t)(t + 2) * kstep; const char* b2 = last ? nB : cB + (size_t)(t + 2) * kstep;
            const char* a3 = a2 + kstep; const char* b3 = b2 + kstep;
            if (last && has_next) S.a_ready(nxt);
            if constexpr (SP2) {
            PG8_LDB(B0, 0, 0); PG8_LDB(B1, 0, 1); PG8_SCHED; PG8_LDA(At, 0, 0); PG8_STAGE(PG8_SA(1, 1), a1 + hstep, voffA);
            PG8_WAIT_V(8); PG8_WAIT_L(0); PG8_BAR; PG8_MMA(0, 0, At, B0); PG8_MMA(0, 1, At, B1); PG8_BAR; PG8_SCHED;
            PG8_LDA(At, 0, 1); PG8_STAGE(PG8_SB(0, 0), b2, voffB); PG8_STAGE(PG8_SB(0, 1), b2 + hstep, voffB); PG8_STAGE(PG8_SA(0, 0), a2, voffA);
            PG8_WAIT_V(8); PG8_WAIT_L(0); PG8_BAR; PG8_MMA(1, 0, At, B0); PG8_MMA(1, 1, At, B1); PG8_BAR; PG8_SCHED;
            PG8_LDB(B0, 1, 0); PG8_LDB(B1, 1, 1); PG8_SCHED; PG8_LDA(At, 1, 0); PG8_STAGE(PG8_SA(0, 1), a2 + hstep, voffA);
            PG8_WAIT_V(8); PG8_WAIT_L(0); PG8_BAR; PG8_MMA(0, 0, At, B0); PG8_MMA(0, 1, At, B1); PG8_BAR; PG8_SCHED;
            PG8_LDA(At, 1, 1); PG8_STAGE(PG8_SB(1, 0), b3, voffB); PG8_STAGE(PG8_SB(1, 1), b3 + hstep, voffB); PG8_STAGE(PG8_SA(1, 0), a3, voffA);
            PG8_WAIT_V(8); PG8_WAIT_L(0); PG8_BAR; PG8_MMA(1, 0, At, B0); PG8_MMA(1, 1, At, B1); PG8_BAR; PG8_SCHED;
            } else {
            PG8_LDB(B0, 0, 0); PG8_SCHED; PG8_LDA(At, 0, 0); PG8_STAGE(PG8_SA(1, 1), a1 + hstep, voffA);
            PG8_WAIT_L(8); PG8_BAR; PG8_WAIT_L(0); PG8_MMA(0, 0, At, B0); PG8_BAR; PG8_SCHED;
            PG8_LDB(B1, 0, 1); PG8_STAGE(PG8_SB(0, 0), b2, voffB);
            PG8_BAR; PG8_WAIT_L(0); PG8_MMA(0, 1, At, B1); PG8_BAR;
            PG8_LDA(At, 0, 1); PG8_STAGE(PG8_SA(0, 0), a2, voffA);
            PG8_BAR; PG8_WAIT_L(0); PG8_MMA(1, 0, At, B0); PG8_BAR; PG8_SCHED;
            PG8_STAGE(PG8_SB(0, 1), b2 + hstep, voffB);
            PG8_WAIT_V(6); PG8_BAR; PG8_MMA(1, 1, At, B1); PG8_BAR;
            PG8_LDB(B0, 1, 0); PG8_SCHED; PG8_LDA(At, 1, 0); PG8_STAGE(PG8_SA(0, 1), a2 + hstep, voffA);
            PG8_WAIT_L(8); PG8_BAR; PG8_WAIT_L(0); PG8_MMA(0, 0, At, B0); PG8_BAR; PG8_SCHED;
            PG8_LDB(B1, 1, 1); PG8_STAGE(PG8_SB(1, 0), b3, voffB);
            PG8_BAR; PG8_WAIT_L(0); PG8_MMA(0, 1, At, B1); PG8_BAR;
            PG8_LDA(At, 1, 1); PG8_STAGE(PG8_SA(1, 0), a3, voffA);
            PG8_BAR; PG8_WAIT_L(0); PG8_MMA(1, 0, At, B0); PG8_BAR; PG8_SCHED;
            PG8_STAGE(PG8_SB(1, 1), b3 + hstep, voffB);
            PG8_WAIT_V(6); PG8_BAR; PG8_MMA(1, 1, At, B1); PG8_BAR;
            }
        }
        if constexpr (FP8) asm volatile("s_nop 15\n\ts_nop 15" ::: "memory");
        if constexpr (ALIGN_EPI) { if (wr == 0) PG8_BAR; }
        if constexpr (I8) E.dequant(acc, cur, wc, fq);
        E(acc, cur, wr, wc, fr, fq); S.done(cur);
        if (!has_next) break;
#pragma unroll
        for (int a = 0; a < 2; ++a)
#pragma unroll
            for (int b = 0; b < 2; ++b)
#pragma unroll
                for (int m = 0; m < 4; ++m)
#pragma unroll
                    for (int n = 0; n < 2; ++n) acc[a][b][m][n] = (f32x4){0.f, 0.f, 0.f, 0.f};
        cur = nxt; cA = nA; cB = nB; ++ui;
        if constexpr (ALIGN_EPI) { if (wr == 1) PG8_BAR; }
    }
    PG8_WAIT_V(0);
    if constexpr (!ALIGN_EPI) { if (wr == 0) PG8_BAR; }
    PG8_BAR;
#undef PG8_SA
#undef PG8_SB
#undef PG8_STAGE
#undef PG8_LDA
#undef PG8_LDB
#undef PG8_MMA
#undef PG8_WAIT_V
#undef PG8_WAIT_L
#undef PG8_BAR
#undef PG8_SCHED
}
}

#define XB_TMO      128
#define XB_XCNT(j)  (256  + 64 * (j))
#define XB_XSUB(j)  (1280 + 64 * (j))
#define XB_XGEN(j)  (2304 + 64 * (j))
#define XB_TOP      3328
#define XB_TOPGEN   3392
#define XCD_BAR_WORDS 3456
#define XB_SPIN_CAP (1u << 18)
DI unsigned xb_ld(unsigned* p)              { return __hip_atomic_load(p, __ATOMIC_RELAXED, __HIP_MEMORY_SCOPE_AGENT); }
DI unsigned xb_add(unsigned* p, unsigned v) { return __hip_atomic_fetch_add(p, v, __ATOMIC_RELAXED, __HIP_MEMORY_SCOPE_AGENT); }
DI unsigned xb_xcc_id() { return (unsigned)__builtin_amdgcn_s_getreg((3 << 11) | 20) & 0xFu; }
#define XB_SPIN(cond, bar) do { unsigned _sp = 0; while (cond) { __builtin_amdgcn_s_sleep(1); \
    if ((++_sp & 255u) == 0u) { if (xb_ld(&(bar)[XB_TMO])) break; if (_sp > XB_SPIN_CAP) { atomicAdd(&(bar)[XB_TMO], 1u); break; } } } } while (0)
struct XcdBarrier { unsigned* bar; unsigned x; volatile LAS unsigned* st; };
DI XcdBarrier xcd_barrier_post(unsigned* bar, volatile LAS unsigned* st) {
    XcdBarrier b; b.bar = bar; b.x = xb_xcc_id(); b.st = st;
    if (threadIdx.x == 0) (void)xb_add(&bar[XB_XCNT(b.x)], 1u);
    return b;
}
DI void xcd_barrier_complete(unsigned* bar, unsigned x, unsigned& nloc, unsigned& nx) {
    const unsigned G = gridDim.x * gridDim.y * gridDim.z;
    unsigned sum, cnt, mine, sp = 0u;
    for (;;) {
        sum = 0u; cnt = 0u; mine = 0u;
#pragma unroll
        for (unsigned j = 0; j < 16; ++j) { const unsigned c = xb_ld(&bar[XB_XCNT(j)]); sum += c; cnt += (c > 0u) ? 1u : 0u; mine = (j == x) ? c : mine; }
        if (sum == G) break;
        __builtin_amdgcn_s_sleep(1);
        if ((++sp & 255u) == 0u) { if (xb_ld(&bar[XB_TMO])) break; if (sp > XB_SPIN_CAP) { atomicAdd(&bar[XB_TMO], 1u); break; } }
    }
    nloc = mine > 0u ? mine : 1u; nx = cnt > 0u ? cnt : 1u;
}
DI void xcd_barrier(const XcdBarrier& b) {
    asm volatile("s_waitcnt vmcnt(0)" ::: "memory");
    __syncthreads();
    if (threadIdx.x == 0) {
        unsigned* bar = b.bar;
        __builtin_amdgcn_s_waitcnt(0);
        unsigned nloc = b.st[0], nx = b.st[1];
        if (nloc == 0u) { xcd_barrier_complete(bar, b.x, nloc, nx); b.st[0] = nloc; b.st[1] = nx; }
        const unsigned old = xb_add(&bar[XB_XSUB(b.x)], 1u);
        const unsigned gen = old / nloc;
        if (old + 1u == (gen + 1u) * nloc) {
            __builtin_amdgcn_fence(__ATOMIC_RELEASE, "agent");
            asm volatile("s_waitcnt vmcnt(0)" ::: "memory");
            const unsigned og = xb_add(&bar[XB_TOP], 1u);
            const unsigned tg = og / nx;
            if (og + 1u == (tg + 1u) * nx) xb_add(&bar[XB_TOPGEN], 1u);
            else XB_SPIN(xb_ld(&bar[XB_TOPGEN]) == tg, bar);
            __builtin_amdgcn_fence(__ATOMIC_ACQUIRE, "agent");
            xb_add(&bar[XB_XGEN(b.x)], 1u);
            asm volatile("s_waitcnt vmcnt(0)" ::: "memory");
        } else {
            XB_SPIN(xb_ld(&bar[XB_XGEN(b.x)]) == gen, bar);
            __builtin_amdgcn_fence(__ATOMIC_ACQUIRE, "agent");
            asm volatile("s_waitcnt vmcnt(0)" ::: "memory");
        }
    }
    __syncthreads();
}

constexpr int NWAVES = 8, NTHREADS = 512;
constexpr int RING_BYTES = 131072, LDSCTL_OFF = RING_BYTES, LDS_BYTES = 147456;
struct Args { const float* in[14]; float* out; unsigned char* ws; int ph_lo, ph_hi; };
struct Frame {
    LAS unsigned char* lds;
    int tid, lane, wave, G, gw, NGW;
    const float *x, *meta, *g_mix, *w_in, *conv_w, *g_q, *g_k, *g_out, *w_out, *g_ffn, *w_query, *sub_keys, *eu, *ev;
    float* out; unsigned char* ws;
};
template <class T> DI T* wsp(const Frame& F, size_t off) { return (T*)(F.ws + off); }

DI unsigned q8(float f) { return (unsigned)__float2int_rn(f) & 255u; }
DI unsigned q8s(float f) { return (unsigned)__float2int_rn(__builtin_amdgcn_fmed3f(f, -127.0f, 127.0f)) & 255u; }
struct RowRegs { f32x4 v[4][2]; };
DI void row_load(RowRegs& r, const float* src, int lane) {
#pragma unroll
    for (int c = 0; c < 4; ++c)
#pragma unroll
        for (int h = 0; h < 2; ++h) r.v[c][h] = __builtin_nontemporal_load((const f32x4*)(src + c * 512 + lane * 8 + 4 * h));
}
DI void row_to_i8(const RowRegs& r, unsigned char* dst, float* rf_out, float* sx_out, int lane) {
    float ss = 0.f, mx = 0.f;
#pragma unroll
    for (int c = 0; c < 4; ++c)
#pragma unroll
        for (int h = 0; h < 2; ++h) { const f32x4 a = r.v[c][h]; ss += (a.x * a.x + a.y * a.y) + (a.z * a.z + a.w * a.w); mx = fmaxf(mx, fmaxf(fmaxf(fabsf(a.x), fabsf(a.y)), fmaxf(fabsf(a.z), fabsf(a.w)))); }
    ss = wave_sum(ss);
#pragma unroll
    for (int o = 1; o < 64; o <<= 1) mx = fmaxf(mx, __shfl_xor(mx, o));
    const float inv = mx > 0.f ? 127.0f / mx : 0.f;
#pragma unroll
    for (int c = 0; c < 4; ++c) { const f32x4 a = r.v[c][0] * inv, b = r.v[c][1] * inv;
        u32x2 o; o.x = q8(a.x) | (q8(a.y) << 8) | (q8(a.z) << 16) | (q8(a.w) << 24); o.y = q8(b.x) | (q8(b.y) << 8) | (q8(b.z) << 16) | (q8(b.w) << 24);
        *(u32x2*)(dst + c * 512 + lane * 8) = o; }
    if (lane == 0) { *rf_out = (1.0f / sqrtf(ss * (1.0f / D) + EPS)) * (mx * (1.0f / 127.0f)); *sx_out = mx * (1.0f / 127.0f); }
}
DI void row_to_o4(const RowRegs& r, unsigned char* dst, float* scale_out, int lane) {
    float mx = 0.f;
#pragma unroll
    for (int c = 0; c < 4; ++c)
#pragma unroll
        for (int h = 0; h < 2; ++h) { const f32x4 a = r.v[c][h]; mx = fmaxf(mx, fmaxf(fmaxf(fabsf(a.x), fabsf(a.y)), fmaxf(fabsf(a.z), fabsf(a.w)))); }
#pragma unroll
    for (int o = 1; o < 64; o <<= 1) mx = fmaxf(mx, __shfl_xor(mx, o));
    const float sc = mx > 0.f ? mx * (0.72f / 7.0f) : 1.0f, inv = 1.0f / sc;
#pragma unroll
    for (int c = 0; c < 4; ++c) { unsigned w = 0u;
#pragma unroll
        for (int k = 0; k < 8; ++k) { const float f = r.v[c][k >> 2][k & 3] * inv; int q = __float2int_rn(f); q = q < -7 ? -7 : (q > 7 ? 7 : q);
            const int nib = (k & 1) ? 4 + (k >> 1) : (k >> 1); w |= (unsigned)(q + 8) << (4 * nib); }
        *(unsigned*)(dst + (size_t)(2 * c + (lane >> 5)) * P_SLB + (lane & 31) * 4) = w; }
    if (lane == 0) *scale_out = sc;
}
DI void row_to_i4(const RowRegs& r, const float* gain, unsigned char* dst, float* scale_out, int lane) {
    f32x4 v[4][2]; float mx = 0.f;
#pragma unroll
    for (int c = 0; c < 4; ++c)
#pragma unroll
        for (int h = 0; h < 2; ++h) { const int e0 = c * 512 + lane * 8 + 4 * h; f32x4 a = r.v[c][h];
            if (gain) a = a * *(const f32x4*)(gain + e0);
            v[c][h] = a; mx = fmaxf(mx, fmaxf(fmaxf(fabsf(a.x), fabsf(a.y)), fmaxf(fabsf(a.z), fabsf(a.w)))); }
#pragma unroll
    for (int o = 1; o < 64; o <<= 1) mx = fmaxf(mx, __shfl_xor(mx, o));
    const float sc = mx > 0.f ? mx * (0.72f / 7.0f) : 1.0f, inv = 1.0f / sc;
#pragma unroll
    for (int c = 0; c < 4; ++c) { unsigned w = 0u;
#pragma unroll
        for (int k = 0; k < 8; ++k) { const float f = v[c][k >> 2][k & 3] * inv; int q = __float2int_rn(f); q = q < -7 ? -7 : (q > 7 ? 7 : q); w |= ((unsigned)q & 15u) << (4 * k); }
        *(unsigned*)(dst + (size_t)(2 * c + (lane >> 5)) * P_SLB + (lane & 31) * 4) = w; }
    if (lane == 0) *scale_out = sc;
}
struct XqRegs { u32x4 v[4]; };
DI void xq_load(XqRegs& r, const bf16* src, int lane) {
#pragma unroll
    for (int i = 0; i < 4; ++i) r.v[i] = *(const u32x4*)(src + lane * 32 + 8 * i);
}
DI void row_to_xq(const XqRegs& r, unsigned char* dst, float* xsc, int lane) {
    float f[32]; float mx = 0.f;
#pragma unroll
    for (int i = 0; i < 4; ++i) { const u32x4 v = r.v[i];
        f[8 * i] = lo_f(v.x); f[8 * i + 1] = hi_f(v.x); f[8 * i + 2] = lo_f(v.y); f[8 * i + 3] = hi_f(v.y); f[8 * i + 4] = lo_f(v.z); f[8 * i + 5] = hi_f(v.z); f[8 * i + 6] = lo_f(v.w); f[8 * i + 7] = hi_f(v.w); }
#pragma unroll
    for (int i = 0; i < 32; ++i) mx = fmaxf(mx, fabsf(f[i]));
    mx = fmaxf(mx, __shfl_xor(mx, 1)); mx = fmaxf(mx, __shfl_xor(mx, 2)); mx = fmaxf(mx, __shfl_xor(mx, 4));
    const float sc = mx > 0.f ? mx * (1.0f / 119.0f) : 1.0f, inv = 1.0f / sc;
    u32x4 wh, wl;
#pragma unroll
    for (int d = 0; d < 4; ++d) { unsigned h = 0u, l = 0u;
#pragma unroll
        for (int k = 0; k < 8; ++k) { const unsigned q8 = (unsigned)__float2int_rn(__builtin_fmaf(f[8 * d + k], inv, 8.0f));
            h |= __builtin_amdgcn_ubfe(q8, 4, 4) << (4 * k); l |= (q8 & 15u) << (4 * k); }
        wh[d] = h; wl[d] = l ^ 0x88888888u; }
    unsigned char* p = dst + (lane >> 3) * 256 + (lane & 7) * 16;
    *(u32x4*)p = wh; *(u32x4*)(p + 128) = wl;
    if ((lane & 7) == 0) xsc[lane >> 3] = sc;
}
constexpr float W2_SCALE = 64.0f;
DI void p0_fold_item(const float* wq, const float* subk, const float* g, unsigned char* W2T, int t, int lane, LAS unsigned char* wl  ) {
    const int hp = t >> 8, kkb = (t >> 6) & 3, kmb = t & 63, p = hp & 1, r = lane & 31, h = lane >> 5;
    const float* A0 = subk + (size_t)(p * 128 + kkb * 32 + (lane >> 3)) * 128 + 4 * (lane & 7);
    const float* B0 = wq + (size_t)(kmb * 32 + (lane >> 3)) * 2048 + hp * 128 + 4 * (lane & 7);
    LAS unsigned char* wst = wl + (lane >> 3) * 144 + (lane & 7) * 16;
    const LAS unsigned char* wld = wl + r * 144 + 16 * h;
    f32x4 la[4], lb[4];
#pragma unroll
    for (int i = 0; i < 4; ++i) { la[i] = *(const f32x4*)(A0 + (size_t)(8 * i) * 128); lb[i] = *(const f32x4*)(B0 + (size_t)(8 * i) * 2048); }
    f32x16 acc;
#pragma unroll
    for (int i = 0; i < 16; ++i) acc[i] = 0.f;
#pragma unroll
    for (int ck = 0; ck < 4; ++ck) {
#pragma unroll
        for (int i = 0; i < 4; ++i) { *(LAS f32x4*)(wst + 8 * i * 144) = la[i]; *(LAS f32x4*)(wst + 4608 + 8 * i * 144) = lb[i]; }
        if (ck < 3) {
#pragma unroll
            for (int i = 0; i < 4; ++i) { la[i] = *(const f32x4*)(A0 + (size_t)(8 * i) * 128 + 32 * (ck + 1)); lb[i] = *(const f32x4*)(B0 + (size_t)(8 * i) * 2048 + 32 * (ck + 1)); } }
#pragma unroll
        for (int q = 0; q < 4; ++q) { const f32x4 a = *(const LAS f32x4*)(wld + 32 * q), b = *(const LAS f32x4*)(wld + 4608 + 32 * q);
            acc = __builtin_amdgcn_mfma_f32_32x32x2f32(a.x, b.x, acc, 0, 0, 0); acc = __builtin_amdgcn_mfma_f32_32x32x2f32(a.y, b.y, acc, 0, 0, 0);
            acc = __builtin_amdgcn_mfma_f32_32x32x2f32(a.z, b.z, acc, 0, 0, 0); acc = __builtin_amdgcn_mfma_f32_32x32x2f32(a.w, b.w, acc, 0, 0, 0); }
    }
    const int km = kmb * 32 + r; const float gk = g[km];
#if G3_FP8
    unsigned char* dst = W2T + (size_t)(hp * 128 + kkb * 32 + 4 * h) * 2048 + km;
#pragma unroll
    for (int i = 0; i < 16; ++i) { const float v = acc[i] * gk * W2_SCALE; dst[(size_t)((i & 3) + 8 * (i >> 2)) * 2048] = (unsigned char)(__builtin_amdgcn_cvt_pk_fp8_f32(v, v, 0, false) & 0xff); }
#else
    bf16* dst = (bf16*)W2T + (size_t)(hp * 128 + kkb * 32 + 4 * h) * 2048 + km;
#pragma unroll
    for (int i = 0; i < 16; ++i) dst[(size_t)((i & 3) + 8 * (i >> 2)) * 2048] = f2bf(acc[i] * gk * W2_SCALE);
#endif
}
DI void p0_panel(Frame& F, int p) {
    const bool first = p < NPROJ / 32;
    const float* W = first ? F.w_in : F.w_out; const float* g = first ? F.g_mix : F.g_out; const int N = first ? NPROJ : D, n0 = 32 * (first ? p : p - NPROJ / 32);
    int ns = n0;
    if (first && n0 >= 1024 && n0 < 3072) { const int t = n0 - 1024, w = t & 255; ns = ((w >> 7) ? 2048 : 1024) + 128 * (t >> 8) + (w & 127); }
    unsigned* CM = (unsigned*)(F.ws + WS_CTL + (first ? CB_CM : CB_CM2)); unsigned char* WT = F.ws + (first ? WS_W1T : WS_WOT); const float f_lo = first ? 1.0f : 2.0f;
    LAS unsigned char* img = F.lds; LAS float* part = (LAS float*)(F.lds + LDSCTL_OFF + 1024);
    const int lane = F.lane, r8 = lane >> 3, c4 = lane & 7;
    f32x4 m = {0.f, 0.f, 0.f, 0.f};
    f32x4 cur[8], nxt[8]; float gc[8], gn[8];
#pragma unroll
    for (int i = 0; i < 8; ++i) { const int k = F.wave * 256 + i * 8 + r8; cur[i] = __builtin_nontemporal_load((const f32x4*)(W + (size_t)k * N + ns + 4 * c4)); gc[i] = g[k]; }
#pragma unroll 1
    for (int bt = 0; bt < 4; ++bt) {
        if (bt < 3) {
#pragma unroll
            for (int i = 0; i < 8; ++i) { const int k = F.wave * 256 + (bt + 1) * 64 + i * 8 + r8; nxt[i] = __builtin_nontemporal_load((const f32x4*)(W + (size_t)k * N + ns + 4 * c4)); gn[i] = g[k]; } }
#pragma unroll
        for (int i = 0; i < 8; ++i) { const int k = F.wave * 256 + bt * 64 + i * 8 + r8;
            const f32x4 v = cur[i] * (gc[i] * (k < 1024 ? f_lo : 1.0f));
            m.x = fmaxf(m.x, fabsf(v.x)); m.y = fmaxf(m.y, fabsf(v.y)); m.z = fmaxf(m.z, fabsf(v.z)); m.w = fmaxf(m.w, fabsf(v.w));
#pragma unroll
            for (int j = 0; j < 4; ++j) *(LAS bf16*)(img + (4 * c4 + j) * 4096 + ((k * 2) ^ (c4 * 8))) = f2bf(v[j]); }
#pragma unroll
        for (int i = 0; i < 8; ++i) { cur[i] = nxt[i]; gc[i] = gn[i]; }
    }
#pragma unroll
    for (int j = 0; j < 4; ++j) { float t = m[j]; t = fmaxf(t, __shfl_xor(t, 8)); t = fmaxf(t, __shfl_xor(t, 16)); t = fmaxf(t, __shfl_xor(t, 32)); if (r8 == 0) part[F.wave * 32 + 4 * c4 + j] = t; }
    __syncthreads();
#pragma unroll
    for (int i = 0; i < 4; ++i) { const int n = F.wave * 4 + i, q4 = (n >> 2) & 7;
        float cm = 0.f;
#pragma unroll
        for (int w = 0; w < 8; ++w) cm = fmaxf(cm, part[w * 32 + n]);
        const float inv = cm > 0.f ? 127.0f / cm : 0.f;
        unsigned o[8];
#pragma unroll
        for (int c = 0; c < 8; ++c) { const u32x2 b = *(const LAS u32x2*)(img + n * 4096 + ((lane * 64 + c * 8) ^ (q4 * 8)));
            o[c] = q8(lo_f(b.x) * inv) | (q8(hi_f(b.x) * inv) << 8) | (q8(lo_f(b.y) * inv) << 16) | (q8(hi_f(b.y) * inv) << 24); }
        unsigned char* dst = WT + (size_t)(n0 + n) * D + lane * 32;
        *(u32x4*)dst = (u32x4){o[0], o[1], o[2], o[3]}; *(u32x4*)(dst + 16) = (u32x4){o[4], o[5], o[6], o[7]};
        if (lane == 0) CM[n0 + n] = __float_as_uint(cm);
    }
    if (first) {
        const int nh = F.wave & 1, kq = F.wave >> 1, l15 = lane & 15, kc = lane >> 4, n = 16 * nh + l15, q4 = (n >> 2) & 7;
        LAS float* red = (LAS float*)(F.lds + LDSCTL_OFF + 1024);
        f32x4 acc = {0.f, 0.f, 0.f, 0.f}; float ss = 0.f;
        __syncthreads();
#pragma unroll 4
        for (int ks = 0; ks < 16; ++ks) { const int k0 = 512 * kq + 32 * ks + 8 * kc;
            const f32x4 m0 = *(const f32x4*)(F.meta + (size_t)l15 * D + k0), m1 = *(const f32x4*)(F.meta + (size_t)l15 * D + k0 + 4);
            ss += ((m0.x * m0.x + m0.y * m0.y) + (m0.z * m0.z + m0.w * m0.w)) + ((m1.x * m1.x + m1.y * m1.y) + (m1.z * m1.z + m1.w * m1.w));
            const u32x2 w0 = *(const LAS u32x2*)(img + n * 4096 + ((k0 * 2) ^ (q4 * 8))), w1 = *(const LAS u32x2*)(img + n * 4096 + ((k0 * 2 + 8) ^ (q4 * 8)));
            const u32x4 wf = {w0.x, w0.y, w1.x, w1.y}, mf = {pk2(m0.x, m0.y), pk2(m0.z, m0.w), pk2(m1.x, m1.y), pk2(m1.z, m1.w)};
            acc = __builtin_amdgcn_mfma_f32_16x16x32_bf16(__builtin_bit_cast(bf16x8, wf), __builtin_bit_cast(bf16x8, mf), acc, 0, 0, 0); }
        ss += __shfl_xor(ss, 16); ss += __shfl_xor(ss, 32);
#pragma unroll
        for (int t = 0; t < 4; ++t) red[((kq * 2 + nh) * 16 + 4 * kc + t) * 16 + l15] = acc[t];
        if (nh == 0 && kc == 0) red[2048 + kq * 16 + l15] = ss;
        __syncthreads();
        { const int r = F.tid & 15, nn = F.tid >> 4;
          float t = 0.f, sq = 0.f;
#pragma unroll
          for (int q = 0; q < 4; ++q) { t += red[((q * 2 + (nn >> 4)) * 16 + (nn & 15)) * 16 + r]; sq += red[2048 + q * 16 + r]; }
          wsp<float>(F, WS_METAP)[(size_t)r * NPROJ + ns + nn] = t / sqrtf(sq * (1.0f / D) + EPS); }
    }
    __syncthreads();
}
DI void p0_prep(Frame& F) {
    for (int p = blockIdx.x; p < NPROJ / 32 + D / 32; p += F.G) p0_panel(F, p);
    constexpr int I_FOLD = 16 * 4 * 64;
    constexpr int NT = I_FOLD + 128   + MR  ;
    RowRegs cur, n1, n2; bool hc = false, h1, h2;
#define P0_ROWIDX(it) ((it) < NT ? ((F.wave & 1) ? (NT - (it)) : (it)) - I_FOLD - 128 : -1)
    { const int ra = P0_ROWIDX(F.gw + F.NGW); h1 = ra >= 0; if (h1) row_load(n1, F.x + (size_t)ra * D, F.lane); }
    for (int it0 = F.gw; it0 < NT; it0 += F.NGW) {
        int r = (F.wave & 1) ? (NT - it0) : it0;
        static_assert(NT % 2 == 0, "item count parity");
        { const int rb = P0_ROWIDX(it0 + 2 * F.NGW); h2 = rb >= 0; if (h2) row_load(n2, F.x + (size_t)rb * D, F.lane); }
        if (r < I_FOLD) p0_fold_item(F.w_query, F.sub_keys, F.g_ffn, wsp<unsigned char>(F, WS_W2T), r, F.lane, F.lds + F.wave * 9216);
        else if (r < I_FOLD + 128) { f32x4* z = (f32x4*)(F.ws + WS_SS1 + (size_t)(r - I_FOLD) * 16384);
#pragma unroll
          for (int i = 0; i < 16; ++i) z[i * 64 + F.lane] = (f32x4){0.f, 0.f, 0.f, 0.f}; }
        else { r -= I_FOLD + 128;
            if (!hc) row_load(cur, F.x + (size_t)r * D, F.lane);
            row_to_i8(cur, wsp<unsigned char>(F, WS_XB) + (size_t)r * D, wsp<float>(F, WS_R0) + r, wsp<float>(F, WS_SX) + r, F.lane); }
        cur = n1; hc = h1; n1 = n2; h1 = h2;
    }
#undef P0_ROWIDX
}
DI void table_rows(Frame& F, int which) {
    unsigned char* V4 = wsp<unsigned char>(F, WS_VB); unsigned char* U4 = wsp<unsigned char>(F, WS_UB);
    for (int blk = blockIdx.x; blk < NEXP / 64; blk += F.G) {
        const int r0 = blk * 64 + F.wave * 8;
        if (which == 2 || which == 4) {
            const float* tab = which == 2 ? F.eu : F.ev;
            RowRegs cur, nx1, nx2; row_load(cur, tab + (size_t)r0 * D, F.lane); row_load(nx1, tab + (size_t)(r0 + 1) * D, F.lane);
            for (int rr = 0; rr < 8; ++rr) { const int e = r0 + rr;
                if (rr < 6) row_load(nx2, tab + (size_t)(e + 2) * D, F.lane);
                if (which == 2) row_to_i4(cur, F.g_ffn, U4 + (size_t)e * P_RB, wsp<float>(F, WS_SU) + 2 * e, F.lane);
                else row_to_o4(cur, V4 + (size_t)e * P_RB, wsp<float>(F, WS_SU) + 2 * e + 1, F.lane);
                cur = nx1; nx1 = nx2; }
        }
        if (which == 6) { XqRegs c, n1, n2; const bf16* hb = wsp<bf16>(F, WS_H1B); xq_load(c, hb + (size_t)r0 * D, F.lane); xq_load(n1, hb + (size_t)(r0 + 1) * D, F.lane);
            for (int rr = 0; rr < 8; ++rr) { const int t = r0 + rr;
                if (rr < 6) xq_load(n2, hb + (size_t)(t + 2) * D, F.lane);
                row_to_xq(c, wsp<unsigned char>(F, WS_XQ) + (size_t)t * 2048, wsp<float>(F, WS_XSC) + (size_t)t * 8, F.lane);
                c = n1; n1 = n2; } }
    }
}

DI size_t k_off(int b, int kidx, int head, int d) { return ((((((size_t)(b * NH + head) * 65 + (kidx >> 5)) * 8 + (d >> 4)) * 2 + ((d >> 3) & 1)) * 32 + (kidx & 31)) * 8) + (d & 7); }
struct EpiG1 {
    static constexpr bool PERM = true, AFTER_DRAIN = false;
    const float* R0; bf16 *GBp, *GCp, *CIp, *Qp, *Kp, *VTp; const float *GQ, *GK; LAS float* PT; const unsigned* CM;
    DI void dequant(f32x4 (&acc)[2][2][4][2], const pg8::Unit& u, int wc, int fq) const {
        const unsigned* cm = CM + u.pn * 256 + wc * 32 + 8 * fq;
#pragma unroll
        for (int bj = 0; bj < 2; ++bj)
#pragma unroll
            for (int n = 0; n < 2; ++n) { const u32x4 cb = *(const u32x4*)(cm + 128 * bj + 4 * n);
                const f32x4 cs = (f32x4){__uint_as_float(cb.x), __uint_as_float(cb.y), __uint_as_float(cb.z), __uint_as_float(cb.w)} * (1.0f / 127.0f);
#pragma unroll
                for (int ai = 0; ai < 2; ++ai)
#pragma unroll
                    for (int m = 0; m < 4; ++m) { const i32x4 iv = __builtin_bit_cast(i32x4, acc[ai][bj][m][n]);
                        acc[ai][bj][m][n] = (f32x4){(float)iv[0], (float)iv[1], (float)iv[2], (float)iv[3]} * cs; } }
    }
    DI void operator()(const f32x4 (&acc)[2][2][4][2], const pg8::Unit& u, int wr, int wc, int fr, int fq) const {
        const int seg = u.pn >> 2, colt = (u.pn & 3) * 256 + wc * 32 + 8 * fq;
        const int row0 = u.pm * 256 + wr * 64 + fr, b = row0 >> 11;
        if (seg == 3 || seg == 4) {
#pragma unroll
            for (int ai = 0; ai < 2; ++ai)
#pragma unroll
                for (int m = 0; m < 4; ++m) { const float rs = R0[row0 + ai * 128 + m * 16];
#pragma unroll
                    for (int bj = 0; bj < 2; ++bj) { const f32x4 v0 = acc[ai][bj][m][0] * rs, v1 = acc[ai][bj][m][1] * rs;
                        float ss = (v0[0] * v0[0] + v0[1] * v0[1]) + (v0[2] * v0[2] + v0[3] * v0[3]) + (v1[0] * v1[0] + v1[1] * v1[1]) + (v1[2] * v1[2] + v1[3] * v1[3]);
                        ss += __shfl_xor(ss, 16); ss += __shfl_xor(ss, 32);
                        if (fq == 0) PT[(ai * 128 + wr * 64 + m * 16 + fr) * 8 + bj * 4 + wc] = ss; } }
            asm volatile("s_waitcnt lgkmcnt(0)" ::: "memory"); __builtin_amdgcn_s_barrier(); asm volatile("" ::: "memory");
            const float* gsrc = (seg == 3 ? GQ : GK) + wc * 32 + 8 * fq; const float sc = (seg == 3) ? QSCALE : 1.0f;
            const f32x4 g0 = *(const f32x4*)gsrc, g1 = *(const f32x4*)(gsrc + 4);
            bf16* base = (seg == 3) ? Qp : Kp; const int radd = (seg == 4) ? (b * (TP - SEQ) + NMETA) : 0;
#pragma unroll
            for (int ai = 0; ai < 2; ++ai)
#pragma unroll
                for (int m = 0; m < 4; ++m) { const int row = row0 + ai * 128 + m * 16; bf16* rowp = base + (size_t)(row + radd) * 1024 + colt;
#pragma unroll
                    for (int bj = 0; bj < 2; ++bj) { const f32x4 pq = *(const LAS f32x4*)(PT + (ai * 128 + wr * 64 + m * 16 + fr) * 8 + bj * 4);
                        const float rn = R0[row] * sc / sqrtf(((pq[0] + pq[1]) + (pq[2] + pq[3])) * (1.0f / DH) + EPS);
                        const f32x4 v0 = acc[ai][bj][m][0] * rn * g0, v1 = acc[ai][bj][m][1] * rn * g1;
                        u32x4 w; w.x = pk2(v0[0], v0[1]); w.y = pk2(v0[2], v0[3]); w.z = pk2(v1[0], v1[1]); w.w = pk2(v1[2], v1[3]);
                        if (seg == 4) *(u32x4*)(Kp + k_off(b, NMETA + (row & 2047), 2 * (u.pn & 3) + bj, wc * 32 + 8 * fq)) = w;
                        else *(u32x4*)(rowp + bj * 128) = w; } }
        } else {
        bf16* base = GBp + (size_t)seg * ((WS_GC - WS_GB) / 2);
#pragma unroll
        for (int ai = 0; ai < 2; ++ai)
#pragma unroll
            for (int m = 0; m < 4; ++m) {
                const int row = row0 + ai * 128 + m * 16; const float rs = R0[row];
                if (seg == 0) {
                    bf16* rowp = base + (size_t)row * 1024 + colt;
#pragma unroll
                    for (int bj = 0; bj < 2; ++bj) { const f32x4 v0 = acc[ai][bj][m][0] * rs, v1 = acc[ai][bj][m][1] * rs;
                        u32x4 w; w.x = pk2(v0[0], v0[1]); w.y = pk2(v0[2], v0[3]); w.z = pk2(v1[0], v1[1]); w.w = pk2(v1[2], v1[3]);
                        *(u32x4*)(rowp + bj * 128) = w; }
                } else if (seg < 3) {
                    const float rs2 = rs * rs; const f32x4 v0 = acc[ai][0][m][0] * acc[ai][1][m][0] * rs2, v1 = acc[ai][0][m][1] * acc[ai][1][m][1] * rs2;
                    u32x4 w; w.x = pk2(v0[0], v0[1]); w.y = pk2(v0[2], v0[3]); w.z = pk2(v1[0], v1[1]); w.w = pk2(v1[2], v1[3]);
                    *(u32x4*)(GCp + (size_t)row * 1024 + (u.pn - 4) * 128 + wc * 32 + 8 * fq) = w;
                } else {
                    const int s = row & 2047;
#pragma unroll
                    for (int bj = 0; bj < 2; ++bj) { const int c = colt + bj * 128;
                        bf16* p = VTp + ((size_t)(b * NH + (c >> 7)) * DH + (c & 127)) * TP + NMETA + s;
#pragma unroll
                        for (int n = 0; n < 2; ++n)
#pragma unroll
                            for (int j = 0; j < 4; ++j) p[(size_t)(n * 4 + j) * TP] = f2bf(acc[ai][bj][m][n][j] * rs); }
                }
            }
        }
    }
};
struct EpiG2 {
    static constexpr bool PERM = true, AFTER_DRAIN = false;
    const unsigned char* X8; const float* SX; bf16* H1B; float* SS1; unsigned char* H1F8; const unsigned* CM;
    DI void dequant(f32x4 (&acc)[2][2][4][2], const pg8::Unit& u, int wc, int fq) const {
        const unsigned* cm = CM + u.pn * 256 + wc * 32 + 8 * fq;
#pragma unroll
        for (int bj = 0; bj < 2; ++bj)
#pragma unroll
            for (int n = 0; n < 2; ++n) { const u32x4 cb = *(const u32x4*)(cm + 128 * bj + 4 * n);
                const f32x4 cs = (f32x4){__uint_as_float(cb.x), __uint_as_float(cb.y), __uint_as_float(cb.z), __uint_as_float(cb.w)} * (1.0f / (127.0f * 2.0f * MIXQ));
#pragma unroll
                for (int ai = 0; ai < 2; ++ai)
#pragma unroll
                    for (int m = 0; m < 4; ++m) { const i32x4 iv = __builtin_bit_cast(i32x4, acc[ai][bj][m][n]);
                        acc[ai][bj][m][n] = (f32x4){(float)iv[0], (float)iv[1], (float)iv[2], (float)iv[3]} * cs; } }
    }
    DI void operator()(const f32x4 (&acc)[2][2][4][2], const pg8::Unit& u, int wr, int wc, int fr, int fq) const {
        const int col0 = u.pn * 256 + wc * 32 + 8 * fq, row0 = u.pm * 256 + wr * 64 + fr;
#pragma unroll
        for (int ai = 0; ai < 2; ++ai)
#pragma unroll
            for (int m = 0; m < 4; ++m) {
                const int row = row0 + ai * 128 + m * 16; float ss = 0.f; const float sx = SX[row];
#pragma unroll
                for (int bj = 0; bj < 2; ++bj) { const size_t off = (size_t)row * D + col0 + bj * 128;
                    const u32x2 xq = *(const u32x2*)(X8 + off);
                    const f32x4 x0 = (f32x4){(float)(int)(signed char)xq.x, (float)(int)(signed char)(xq.x >> 8), (float)(int)(signed char)(xq.x >> 16), (float)((int)xq.x >> 24)} * sx,
                                x1 = (f32x4){(float)(int)(signed char)xq.y, (float)(int)(signed char)(xq.y >> 8), (float)(int)(signed char)(xq.y >> 16), (float)((int)xq.y >> 24)} * sx;
                    const f32x4 h0 = x0 + acc[ai][bj][m][0], h1 = x1 + acc[ai][bj][m][1];
                    u32x4 w; w.x = pk2(h0[0], h0[1]); w.y = pk2(h0[2], h0[3]); w.z = pk2(h1[0], h1[1]); w.w = pk2(h1[2], h1[3]);
                    *(u32x4*)(H1B + off) = w;
                    if (G3_FP8) { unsigned f0 = __builtin_amdgcn_cvt_pk_fp8_f32(h0[0], h0[1], 0, false); f0 = __builtin_amdgcn_cvt_pk_fp8_f32(h0[2], h0[3], f0, true);
                      unsigned f1 = __builtin_amdgcn_cvt_pk_fp8_f32(h1[0], h1[1], 0, false); f1 = __builtin_amdgcn_cvt_pk_fp8_f32(h1[2], h1[3], f1, true);
                      *(u32x2*)(H1F8 + off) = (u32x2){f0, f1}; }
                    ss += (h0[0] * h0[0] + h0[1] * h0[1]) + (h0[2] * h0[2] + h0[3] * h0[3]) + (h1[0] * h1[0] + h1[1] * h1[1]) + (h1[2] * h1[2] + h1[3] * h1[3]); }
                ss += __shfl_xor(ss, 16); ss += __shfl_xor(ss, 32);
                if (fq == 0) SS1[(size_t)(u.pn * 4 + wc) * MR + row] = ss;
            }
    }
};
struct EpiG3 {
    static constexpr bool PERM = true, AFTER_DRAIN = false;
    unsigned short* SC;
    DI void operator()(const f32x4 (&acc)[2][2][4][2], const pg8::Unit& u, int wr, int wc, int fr, int fq) const {
        const int row0 = u.pm * 256 + wr * 64 + fr;
#pragma unroll
        for (int ai = 0; ai < 2; ++ai)
#pragma unroll
            for (int m = 0; m < 4; ++m) { const int tok = row0 + ai * 128 + m * 16;
                unsigned short* rowp = SC + ((size_t)((tok >> 6) * 8 + u.pn) * 32 * 64 + (tok & 63)) * 8 + (size_t)(4 * wc + fq) * 512;
#pragma unroll
                for (int bj = 0; bj < 2; ++bj) { const f32x4 v0 = acc[ai][bj][m][0] * (1.0f / W2_SCALE), v1 = acc[ai][bj][m][1] * (1.0f / W2_SCALE);
                    u32x4 w; w.x = pkh2(v0[0], v0[1]); w.y = pkh2(v0[2], v0[3]); w.z = pkh2(v1[0], v1[1]); w.w = pkh2(v1[2], v1[3]);
                    *(u32x4*)(rowp + bj * (16 * 512)) = w; } }
    }
};

DI float sum16(float v) { v += __shfl_xor(v, 1); v += __shfl_xor(v, 2); v += __shfl_xor(v, 4); v += __shfl_xor(v, 8); return v; }
DI void unpack8(const u32x4 v, float (&f)[8]) { f[0] = lo_f(v.x); f[1] = hi_f(v.x); f[2] = lo_f(v.y); f[3] = hi_f(v.y); f[4] = lo_f(v.z); f[5] = hi_f(v.z); f[6] = lo_f(v.w); f[7] = hi_f(v.w); }
DI u32x4 pack8(const float (&f)[8]) { u32x4 o; o.x = pk2(f[0], f[1]); o.y = pk2(f[2], f[3]); o.z = pk2(f[4], f[5]); o.w = pk2(f[6], f[7]); return o; }
template <int MODE  >
DI void p2_norm_conv(Frame& F) {
    bf16* GBp = wsp<bf16>(F, WS_GB); bf16* GCp = wsp<bf16>(F, WS_GC); bf16* CIp = wsp<bf16>(F, WS_CI); bf16* Qp = wsp<bf16>(F, WS_Q); bf16* Kp = wsp<bf16>(F, WS_K);
    bf16* VTp = wsp<bf16>(F, WS_VT); unsigned char* MIX = wsp<unsigned char>(F, WS_MIX); const float* MP = wsp<float>(F, WS_METAP);
    const int lane = F.lane;
    constexpr int NRUN = MR / 8;
    constexpr int NT = NRUN + NB * NMETA   + NB * NMETA   + NB * NH  ;
    for (int it = (MODE == 0 ? F.gw : NRUN + F.gw); it < (MODE == 0 ? NRUN : NT); it += F.NGW) {
        int r = it;
        if (r < NRUN) {
            const int m0 = r * 8, s0 = m0 & 2047;
            float w0[2][8], w1[2][8], w2[2][8], u1[2][8], u2[2][8];
#pragma unroll
            for (int c = 0; c < 2; ++c) { const int ch = c * 512 + lane * 8;
#pragma unroll
                for (int j = 0; j < 8; ++j) { w0[c][j] = F.conv_w[ch + j]; w1[c][j] = F.conv_w[DC + ch + j]; w2[c][j] = F.conv_w[2 * DC + ch + j]; }
                if (s0 == 0) {
#pragma unroll
                    for (int j = 0; j < 8; ++j) { u2[c][j] = MP[(size_t)14 * NPROJ + 1024 + ch + j] * MP[(size_t)14 * NPROJ + 2048 + ch + j];
                                                  u1[c][j] = MP[(size_t)15 * NPROJ + 1024 + ch + j] * MP[(size_t)15 * NPROJ + 2048 + ch + j]; }
                } else {
                    unpack8(*(const u32x4*)(GCp + (size_t)(m0 - 2) * 1024 + ch), u2[c]);
                    unpack8(*(const u32x4*)(GCp + (size_t)(m0 - 1) * 1024 + ch), u1[c]);
                }
            }
            u32x4 gcur[2], ucur[2], gnx[2], unx[2];
#pragma unroll
            for (int c = 0; c < 2; ++c) { const int ch = c * 512 + lane * 8; gcur[c] = __builtin_nontemporal_load((const u32x4*)(GBp + (size_t)m0 * 1024 + ch)); ucur[c] = __builtin_nontemporal_load((const u32x4*)(GCp + (size_t)m0 * 1024 + ch)); }
            for (int tk = 0; tk < 8; ++tk) {
                const int m = m0 + tk, b = m >> 11, s = m & 2047;
                if (tk + 1 < 8) {
#pragma unroll
                    for (int c = 0; c < 2; ++c) { const int ch = c * 512 + lane * 8; gnx[c] = __builtin_nontemporal_load((const u32x4*)(GBp + (size_t)(m + 1) * 1024 + ch)); unx[c] = __builtin_nontemporal_load((const u32x4*)(GCp + (size_t)(m + 1) * 1024 + ch)); } }
#pragma unroll
                for (int c = 0; c < 2; ++c) { const int ch = c * 512 + lane * 8;
                    float gb[8], uu[8], y[8];
                    unpack8(gcur[c], gb); unpack8(ucur[c], uu);
                    float ss = 0.f;
#pragma unroll
                    for (int j = 0; j < 8; ++j) { const float u0 = uu[j]; y[j] = gb[j] * (w0[c][j] * u2[c][j] + w1[c][j] * u1[c][j] + w2[c][j] * u0); u2[c][j] = u1[c][j]; u1[c][j] = u0; ss += y[j] * y[j]; }
                    ss = sum16(ss); const float rs = 1.0f / sqrtf(ss * (1.0f / 128.0f) + EPS);
#pragma unroll
                    for (int j = 0; j < 8; ++j) y[j] *= rs * MIXQ;
                    { u32x2 o; o.x = q8(y[0]) | (q8(y[1]) << 8) | (q8(y[2]) << 16) | (q8(y[3]) << 24); o.y = q8(y[4]) | (q8(y[5]) << 8) | (q8(y[6]) << 16) | (q8(y[7]) << 24);
                      *(u32x2*)(MIX + (size_t)m * D + ch) = o; }
                }
#pragma unroll
                for (int c = 0; c < 2; ++c) { gcur[c] = gnx[c]; ucur[c] = unx[c]; }
            }
            continue;
        }
        r -= NRUN;
        if (r < NB * NMETA) {
            const int b = r >> 4, rr = r & 15; bf16* row = Kp + (size_t)(b * TP + rr) * 1024;
#pragma unroll
            for (int c = 0; c < 2; ++c) { const int ch = c * 512 + lane * 8; float f[8]; float ss = 0.f;
#pragma unroll
                for (int j = 0; j < 8; ++j) { f[j] = MP[(size_t)rr * NPROJ + 4096 + ch + j]; ss += f[j] * f[j]; }
                ss = sum16(ss); const float rs = 1.0f / sqrtf(ss * (1.0f / DH) + EPS); const int d0 = (lane & 15) * 8;
#pragma unroll
                for (int j = 0; j < 8; ++j) f[j] = f[j] * rs * F.g_k[d0 + j];
                *(u32x4*)(Kp + k_off(b, rr, ch >> 7, ch & 127)) = pack8(f); }
            continue;
        }
        r -= NB * NMETA;
        if (r < NB * NMETA) {
            const int b = r >> 4, rr = r & 15; bf16* row = Kp + (size_t)(b * TP + TT + rr) * 1024;
            *(u32x4*)(Kp + k_off(b, TT + rr, (lane * 8) >> 7, (lane * 8) & 127)) = (u32x4){0u, 0u, 0u, 0u}; *(u32x4*)(Kp + k_off(b, TT + rr, (512 + lane * 8) >> 7, (lane * 8) & 127)) = (u32x4){0u, 0u, 0u, 0u};
            continue;
        }
        r -= NB * NMETA;
        {
            const int b = r >> 3, hh = r & 7;
#pragma unroll
            for (int dd = 0; dd < 2; ++dd) { const int d = 2 * lane + dd; bf16* col = VTp + ((size_t)(b * NH + hh) * DH + d) * TP;
                float f[8], g[8];
#pragma unroll
                for (int j = 0; j < 8; ++j) { f[j] = MP[(size_t)j * NPROJ + 5120 + hh * 128 + d]; g[j] = MP[(size_t)(8 + j) * NPROJ + 5120 + hh * 128 + d]; }
                *(u32x4*)col = pack8(f); *(u32x4*)(col + 8) = pack8(g);
                *(u32x4*)(col + TT) = (u32x4){0u, 0u, 0u, 0u}; *(u32x4*)(col + TT + 8) = (u32x4){0u, 0u, 0u, 0u}; }
        }
    }
}

DI void attn_simple(Frame& F) {
    const bf16* Qp = wsp<bf16>(F, WS_Q); const bf16* Kp = wsp<bf16>(F, WS_K); const bf16* VTp = wsp<bf16>(F, WS_VT); unsigned char* MIX = wsp<unsigned char>(F, WS_MIX);
    const int lane = F.lane;
    for (int it = F.gw; it < MR * NH; it += F.NGW) {
        const int m = it >> 3, hh = it & 7, b = m >> 11, s = m & 2047, t = NMETA + s;
        const unsigned qd = *(const unsigned*)(Qp + (size_t)m * 1024 + hh * 128 + 2 * lane);
        const bf16* v0p = VTp + ((size_t)(b * NH + hh) * DH + 2 * lane) * TP; const bf16* v1p = v0p + TP;
        float a0 = 0.f, a1 = 0.f, R = 0.f;
        for (int tk = t - 1; tk >= 0; --tk) {
            const unsigned kd = *(const unsigned*)(Kp + k_off(b, tk, hh, 2 * lane));
            const float z = wave_sum(dot2bf(qd, kd, 0.f));
            const float l2 = __builtin_amdgcn_logf(1.0f + __builtin_amdgcn_exp2f(-fabsf(z)));
            const float sp = fmaxf(z, 0.f) + l2;
            const float w = __builtin_amdgcn_exp2f((z - sp) + R);
            R -= sp;
            a0 += w * bf2f(v0p[tk]); a1 += w * bf2f(v1p[tk]);
        }
        const float ss = wave_sum(a0 * a0 + a1 * a1), rs = 1.0f / sqrtf(ss * (1.0f / DH) + EPS);
        *(unsigned short*)(MIX + (size_t)m * D + DC + hh * 128 + 2 * lane) = (unsigned short)(q8s(a0 * rs * (2.0f * MIXQ)) | (q8s(a1 * rs * (2.0f * MIXQ)) << 8));
    }
}

DI void attn_fast(Frame& F) {
    const bf16* Qp = wsp<bf16>(F, WS_Q); const bf16* Kp = wsp<bf16>(F, WS_K); const bf16* VTp = wsp<bf16>(F, WS_VT); unsigned char* MIX = wsp<unsigned char>(F, WS_MIX);
    const int lane = F.lane, qq = lane & 31, hlf = lane >> 5;
    const int pi = 16 * ((qq >> 2) & 1) + (qq & 3) + 4 * (qq >> 3);
    constexpr int NQB = 65, NTASK = NB * NH * NQB;
    for (int it = F.gw; it < NTASK; it += F.NGW) {
        const int qb = it < 64 * 64 ? 1 + (it & 63) : 0, bh = it < 64 * 64 ? (it >> 6) : it - 64 * 64, b = bh >> 3, hh = bh & 7;
        const int tq = 32 * qb + qq; const bool qvalid = (tq >= NMETA) && (tq < TT);
        int s = tq - NMETA; s = s < 0 ? 0 : (s > SEQ - 1 ? SEQ - 1 : s);
        const int m = b * SEQ + s;
        bf16x8 qf[8];
        { const bf16* qrow = Qp + (size_t)m * 1024 + hh * 128 + 8 * hlf;
#pragma unroll
          for (int ks = 0; ks < 8; ++ks) qf[ks] = *(const bf16x8*)(qrow + 16 * ks); }
        f32x16 o[4];
#pragma unroll
        for (int d = 0; d < 4; ++d)
#pragma unroll
            for (int r = 0; r < 16; ++r) o[d][r] = 0.f;
        float carry = 0.f;
        const bf16* kbase = Kp + k_off(b, pi, hh, 8 * hlf);
        const bf16* vbase = VTp + ((size_t)(b * NH + hh) * DH + qq) * TP + 16 * hlf;
        bf16x8 kf[8];
#pragma unroll
        for (int ks = 0; ks < 8; ++ks) kf[ks] = *(const bf16x8*)(kbase + (size_t)qb * 4096 + 512 * ks);
        const int thr = qq - 16 * hlf;
        bf16x8 vf[4][2];
#pragma unroll
        for (int d = 0; d < 4; ++d)
#pragma unroll
            for (int sx = 0; sx < 2; ++sx) vf[d][sx] = *(const bf16x8*)(vbase + (size_t)d * 32 * TP + qb * 32 + 8 * sx);
        for (int jt = qb; jt >= 0; --jt) {
            f32x16 st;
#pragma unroll
            for (int r = 0; r < 16; ++r) st[r] = 0.f;
#pragma unroll
            for (int ks = 0; ks < 8; ++ks) st = __builtin_amdgcn_mfma_f32_32x32x16_bf16(kf[ks], qf[ks], st, 0, 0, 0);
            { const int jn = jt > 0 ? jt - 1 : 0;
#pragma unroll
              for (int ks = 0; ks < 8; ++ks) kf[ks] = *(const bf16x8*)(kbase + (size_t)jn * 4096 + 512 * ks); }
            const bool diag = (jt == qb);
            float sp[16], lb[16]; float tot = 0.f;
#pragma unroll
            for (int r = 0; r < 16; ++r) {
                const float z = st[r];
                const float l2 = __builtin_amdgcn_logf(1.0f + __builtin_amdgcn_exp2f(-fabsf(z)));
                float spv = fmaxf(z, 0.f) + l2; lb[r] = fminf(z, 0.f) - l2;
                if (diag && !(r < thr)) spv = 0.f;
                sp[r] = spv; tot += spv;
            }
            const float tot_o = __shfl_xor(tot, 32);
            float run = carry + (hlf ? 0.f : tot_o);
            float w[16];
#pragma unroll
            for (int r = 15; r >= 0; --r) {
                float wv = __builtin_amdgcn_exp2f(lb[r] - run);
                if (diag && !(r < thr)) wv = 0.f;
                w[r] = wv; run += sp[r];
            }
            carry += tot + tot_o;
#pragma unroll
            for (int sx = 0; sx < 2; ++sx) {
                u32x4 pw; pw.x = pk2(w[8 * sx + 0], w[8 * sx + 1]); pw.y = pk2(w[8 * sx + 2], w[8 * sx + 3]); pw.z = pk2(w[8 * sx + 4], w[8 * sx + 5]); pw.w = pk2(w[8 * sx + 6], w[8 * sx + 7]);
                const bf16x8 wb = __builtin_bit_cast(bf16x8, pw);
#pragma unroll
                for (int d = 0; d < 4; ++d) o[d] = __builtin_amdgcn_mfma_f32_32x32x16_bf16(vf[d][sx], wb, o[d], 0, 0, 0);
            }
            { const int jn = jt > 0 ? jt - 1 : 0;
#pragma unroll
              for (int d = 0; d < 4; ++d)
#pragma unroll
                  for (int sx = 0; sx < 2; ++sx) vf[d][sx] = *(const bf16x8*)(vbase + (size_t)d * 32 * TP + jn * 32 + 8 * sx); }
            if (__all((!qvalid) || (carry >= ATTN_EXIT))) break;
        }
        float ss = 0.f;
#pragma unroll
        for (int d = 0; d < 4; ++d)
#pragma unroll
            for (int r = 0; r < 16; ++r) ss += o[d][r] * o[d][r];
        ss += __shfl_xor(ss, 32);
        const float rs = 1.0f / sqrtf(ss * (1.0f / DH) + EPS);
        {
            unsigned char* orow = MIX + (size_t)m * D + DC + hh * 128 + 16 * hlf; const float rq = rs * (2.0f * MIXQ);
#pragma unroll
            for (int d = 0; d < 4; ++d) { unsigned w[4];
#pragma unroll
                for (int g = 0; g < 4; ++g) w[g] = q8s(o[d][4 * g] * rq) | (q8s(o[d][4 * g + 1] * rq) << 8) | (q8s(o[d][4 * g + 2] * rq) << 16) | (q8s(o[d][4 * g + 3] * rq) << 24);
                asm volatile("s_nop 1\n\tv_permlane32_swap_b32 %0, %1" : "+v"(w[0]), "+v"(w[2]));
                asm volatile("s_nop 1\n\tv_permlane32_swap_b32 %0, %1" : "+v"(w[1]), "+v"(w[3]));
                if (qvalid) *(u32x4*)(orow + 32 * d) = (u32x4){w[0], w[2], w[1], w[3]}; }
        }
    }
}

DI void cex_desc(float& a, float& b) { const float hi = fmaxf(a, b), lo = fminf(a, b); a = hi; b = lo; }
#define SORT16_NET(CE) CE(0,1) CE(2,3) CE(4,5) CE(6,7) CE(8,9) CE(10,11) CE(12,13) CE(14,15) CE(0,2) CE(1,3) CE(4,6) CE(5,7) CE(8,10) CE(9,11) CE(12,14) CE(13,15) CE(1,2) CE(5,6) CE(9,10) CE(13,14) CE(0,4) CE(1,5) CE(2,6) CE(3,7) CE(8,12) CE(9,13) CE(10,14) CE(11,15) CE(2,4) CE(3,5) CE(10,12) CE(11,13) CE(1,2) CE(3,4) CE(5,6) CE(9,10) CE(11,12) CE(13,14) CE(0,8) CE(1,9) CE(2,10) CE(3,11) CE(4,12) CE(5,13) CE(6,14) CE(7,15) CE(4,8) CE(5,9) CE(6,10) CE(7,11) CE(2,4) CE(3,5) CE(6,8) CE(7,9) CE(10,12) CE(11,13) CE(1,2) CE(3,4) CE(5,6) CE(7,8) CE(9,10) CE(11,12) CE(13,14)
#define SORT16_MERGES(CE) CE(0,4) CE(1,5) CE(2,6) CE(3,7) CE(8,12) CE(9,13) CE(10,14) CE(11,15) CE(2,4) CE(3,5) CE(10,12) CE(11,13) CE(1,2) CE(3,4) CE(5,6) CE(9,10) CE(11,12) CE(13,14) CE(0,8) CE(1,9) CE(2,10) CE(3,11) CE(4,12) CE(5,13) CE(6,14) CE(7,15) CE(4,8) CE(5,9) CE(6,10) CE(7,11) CE(2,4) CE(3,5) CE(6,8) CE(7,9) CE(10,12) CE(11,13) CE(1,2) CE(3,4) CE(5,6) CE(7,8) CE(9,10) CE(11,12) CE(13,14)
DI void sort4_desc(float& a, float& b, float& c, float& d) {
    const float hi = fmaxf(fmaxf(a, b), c), lo = fminf(fminf(a, b), c), md = __builtin_amdgcn_fmed3f(a, b, c);
    a = fmaxf(hi, d); b = __builtin_amdgcn_fmed3f(hi, md, d); c = __builtin_amdgcn_fmed3f(md, lo, d); d = fminf(lo, d);
}
DI void sort16_desc(float (&v)[16]) {
#pragma unroll
    for (int g = 0; g < 4; ++g) sort4_desc(v[4 * g], v[4 * g + 1], v[4 * g + 2], v[4 * g + 3]);
#define CE(a, b) cex_desc(v[a], v[b]);
    SORT16_MERGES(CE)
#undef CE
}
DI void merge16_desc(float (&L)[16], const float (&M)[16]) {
#pragma unroll
    for (int i = 0; i < 16; ++i) L[i] = fmaxf(L[i], M[15 - i]);
#pragma unroll
    for (int j = 8; j > 0; j >>= 1)
#pragma unroll
        for (int i = 0; i < 16; ++i) if ((i & j) == 0) cex_desc(L[i], L[i + j]);
}
DI int mkey(float sum, int code) { const int r = (int)__float_as_uint(sum); return ((r ^ ((r >> 31) & 0x7fffffff)) & ~255) | (255 - code); }
DI float munkey(int k) { k &= ~255; return __uint_as_float((unsigned)(k ^ ((k >> 31) & 0x7fffffff))); }
DI void cexi_desc(int& a, int& b) { const int hi = max(a, b), lo = min(a, b); a = hi; b = lo; }
DI void sort16i_desc(int (&v)[16]) {
#define CE(a, b) cexi_desc(v[a], v[b]);
    SORT16_NET(CE)
#undef CE
}
template <int N> DI void mergei_desc(int (&L)[16], const int (&M)[N]) {
#pragma unroll
    for (int i = 0; i < N; ++i) L[15 - i] = max(L[15 - i], M[i]);
#pragma unroll
    for (int j = 8; j > 0; j >>= 1)
#pragma unroll
        for (int i = 0; i < 16; ++i) if ((i & j) == 0) cexi_desc(L[i], L[i + j]);
}
struct Raw16 { u32x4 v[2]; };
DI void raw16(const unsigned short* sp, int c16, Raw16& r) { r.v[0] = *(const u32x4*)(sp + 512 * (2 * c16)); r.v[1] = *(const u32x4*)(sp + 512 * (2 * c16 + 1)); }
DI void unpack16(const Raw16& r, int c16, float (&M)[16]) {
#pragma unroll
    for (int h = 0; h < 2; ++h)
#pragma unroll
        for (int e = 0; e < 4; ++e) { const f32x2 f = unpkh2(r.v[h][e]);
            M[8 * h + 2 * e] = __uint_as_float(__float_as_uint(f.x) | (unsigned)(16 * c16 + 8 * h + 2 * e));
            M[8 * h + 2 * e + 1] = __uint_as_float(__float_as_uint(f.y) | (unsigned)(16 * c16 + 8 * h + 2 * e + 1)); }
}
DI void scan128(const unsigned short* sp, float (&L)[16]) {
    Raw16 cur, nxt; raw16(sp, 0, cur); raw16(sp, 1, nxt);
    unpack16(cur, 0, L); sort16_desc(L);
#pragma unroll 1
    for (int c = 1; c < 8; ++c) { cur = nxt; if (c < 7) raw16(sp, c + 1, nxt);
        float M[16]; unpack16(cur, c, M); sort16_desc(M); merge16_desc(L, M); }
}
template <bool OWN  >
DI void topk_fast(Frame& F) {
    const unsigned short* SC = wsp<unsigned short>(F, WS_SC); const float* SS1 = wsp<float>(F, WS_SS1); float* R1 = wsp<float>(F, WS_R1); u32x4* PAIRS = wsp<u32x4>(F, WS_PAIRS);
    LAS unsigned char* slot = F.lds + F.tid * 32;
    pg8::StaticOrder S; S.init(MR, D, F.G, (int)blockIdx.x);
    for (int gl = OWN ? F.tid : blockIdx.x * NTHREADS + F.tid; ; gl += OWN ? NTHREADS : F.G * NTHREADS) {
        int m, hh;
        if (OWN) { pg8::Unit u; if (!S.next(gl >> 8, u)) break; m = u.pm * 256 + (gl & 255); hh = u.pn; }
        else { if (gl >= MR * PEER_H) break; m = gl >> 3; hh = gl & 7; }
        float ssv[32];
#pragma unroll
        for (int sl = 0; sl < 32; ++sl) ssv[sl] = SS1[(size_t)sl * MR + m];
        float A[16], B[16];
        { const unsigned short* lp = SC + ((size_t)((m >> 6) * 8 + hh) * 32 * 64 + (m & 63)) * 8;
          scan128(lp, A);
          scan128(lp + 16 * 512, B); }
        float ssq = 0.f;
#pragma unroll
        for (int sl = 0; sl < 32; ++sl) ssq += ssv[sl];
        const float r1 = 1.0f / sqrtf(ssq * (1.0f / D) + EPS);
        if (hh == 0) R1[m] = r1;
        { u32x4 wa, wb; unsigned t[8];
#pragma unroll
          for (int q = 0; q < 4; ++q) { t[q] = (__float_as_uint(A[4 * q]) & 127u) | ((__float_as_uint(A[4 * q + 1]) & 127u) << 8) | ((__float_as_uint(A[4 * q + 2]) & 127u) << 16) | ((__float_as_uint(A[4 * q + 3]) & 127u) << 24);
                                         t[4 + q] = (__float_as_uint(B[4 * q]) & 127u) | ((__float_as_uint(B[4 * q + 1]) & 127u) << 8) | ((__float_as_uint(B[4 * q + 2]) & 127u) << 16) | ((__float_as_uint(B[4 * q + 3]) & 127u) << 24); }
          wa.x = t[0]; wa.y = t[1]; wa.z = t[2]; wa.w = t[3]; wb.x = t[4]; wb.y = t[5]; wb.z = t[6]; wb.w = t[7];
          *(LAS u32x4*)slot = wa; *(LAS u32x4*)(slot + 16) = wb; }
        float As[16], Bs[16];
#pragma unroll
        for (int k = 0; k < 16; ++k) { As[k] = __uint_as_float(__float_as_uint(A[k]) & ~127u); Bs[k] = __uint_as_float(__float_as_uint(B[k]) & ~127u); }
        int C[16];
#pragma unroll
        for (int j = 0; j < 16; ++j) C[j] = mkey(As[0] + Bs[j], j);
        { int M[8];
#pragma unroll
          for (int j = 0; j < 8; ++j) M[j] = mkey(As[1] + Bs[j], 16 + j);
          mergei_desc<8>(C, M); }
        { int M[8];
#pragma unroll
          for (int i = 8; i < 16; ++i) M[i - 8] = mkey(As[i] + Bs[0], i * 16);
          mergei_desc<8>(C, M); }
        { int M[16];
#pragma unroll
          for (int j = 0; j < 5; ++j) M[j] = mkey(As[2] + Bs[j], 32 + j);
#pragma unroll
          for (int j = 0; j < 4; ++j) M[5 + j] = mkey(As[3] + Bs[j], 48 + j);
#pragma unroll
          for (int j = 0; j < 3; ++j) M[9 + j] = mkey(As[4] + Bs[j], 64 + j);
#pragma unroll
          for (int j = 0; j < 2; ++j) { M[12 + j] = mkey(As[5] + Bs[j], 80 + j); M[14 + j] = mkey(As[6] + Bs[j], 96 + j); }
          sort16i_desc(M); mergei_desc<16>(C, M); }
        { int M[2];
#pragma unroll
          for (int j = 0; j < 2; ++j) M[j] = mkey(As[7] + Bs[j], 112 + j);
          mergei_desc<2>(C, M); }
        const float top = munkey(C[0]);
        float ex[16]; float den = 0.f; unsigned eid[16];
#pragma unroll
        for (int k = 0; k < 16; ++k) { const unsigned code = 255u - ((unsigned)C[k] & 255u);
            ex[k] = __expf((munkey(C[k]) - top) * r1); den += ex[k];
            eid[k] = (unsigned)slot[code >> 4] * NKEYS + (unsigned)slot[16 + (code & 15u)]; }
        const float inv = 1.0f / den;
        if constexpr (OWN) {
            LAS unsigned char* wl = F.lds + 32768 + F.wave * 9216; const int lane = F.lane;
#pragma unroll
            for (int k = 0; k < 16; k += 4) { *(LAS u32x4*)(wl + lane * 144 + k * 4) = (u32x4){eid[k], eid[k + 1], eid[k + 2], eid[k + 3]};
                *(LAS u32x4*)(wl + lane * 144 + 64 + k * 4) = (u32x4){__float_as_uint(ex[k] * inv), __float_as_uint(ex[k + 1] * inv), __float_as_uint(ex[k + 2] * inv), __float_as_uint(ex[k + 3] * inv)}; }
            u32x4* dst = PAIRS + ((size_t)(m - lane) * 128 + hh * PEER_K) / 4;
#pragma unroll
            for (int i = 0; i < 4; ++i) { const int t = 16 * i + (lane >> 2), q4 = lane & 3;
                dst[(size_t)t * 32 + q4] = *(const LAS u32x4*)(wl + t * 144 + q4 * 16);
                dst[(8 * MiB) / 16 + (size_t)t * 32 + q4] = *(const LAS u32x4*)(wl + t * 144 + 64 + q4 * 16); }
        } else {
            u32x4* dst = PAIRS + ((size_t)m * 128 + hh * PEER_K) / 4;
#pragma unroll
            for (int k = 0; k < 16; k += 4) { dst[k / 4] = (u32x4){eid[k], eid[k + 1], eid[k + 2], eid[k + 3]};
                dst[(8 * MiB) / 16 + k / 4] = (u32x4){__float_as_uint(ex[k] * inv), __float_as_uint(ex[k + 1] * inv), __float_as_uint(ex[k + 2] * inv), __float_as_uint(ex[k + 3] * inv)}; }
        }
    }
}

struct PdUnit { u32x4 w[16]; u32x4 xr[2]; float xs; };
DI void pd_issue(PdUnit& u, const unsigned char* ub, const bf16* xrow, const float* xsp, unsigned e0, unsigned e1, int grp) {
#pragma unroll
    for (int q = 0; q < 16; ++q) { const unsigned e = (unsigned)__shfl((int)(q < 8 ? e0 : e1), (q & 7) * 8 + grp); u.w[q] = *(const u32x4*)(ub + (size_t)e * P_RB); }
    u.xr[0] = *(const u32x4*)xrow; u.xr[1] = *(const u32x4*)((const unsigned char*)xrow + 128); u.xs = *xsp;
}
DI void pd_compute(const PdUnit& u, unsigned* pd, int sub) {
    float d[16];
#pragma unroll
    for (int q = 0; q < 16; ++q) { int ah = 0, al = 0;
#pragma unroll
        for (int c = 0; c < 4; ++c) { ah = __builtin_amdgcn_sdot8((int)u.w[q][c], (int)u.xr[0][c], ah, false); al = __builtin_amdgcn_sdot8((int)u.w[q][c], (int)u.xr[1][c], al, false); }
        d[q] = (float)(16 * ah + al) * u.xs; }
    float k8[8], k4[4], k2[2];
    const bool b4 = (sub & 4) != 0, b2 = (sub & 2) != 0, b1 = (sub & 1) != 0;
#pragma unroll
    for (int q = 0; q < 8; ++q) { const float snd = b4 ? d[q] : d[q + 8]; k8[q] = (b4 ? d[q + 8] : d[q]) + __shfl_xor(snd, 4); }
#pragma unroll
    for (int q = 0; q < 4; ++q) { const float snd = b2 ? k8[q] : k8[q + 4]; k4[q] = (b2 ? k8[q + 4] : k8[q]) + __shfl_xor(snd, 2); }
#pragma unroll
    for (int q = 0; q < 2; ++q) { const float snd = b1 ? k4[q] : k4[q + 2]; k2[q] = (b1 ? k4[q + 2] : k4[q]) + __shfl_xor(snd, 1); }
    const int i0 = (b1 ? 2 : 0) + (b2 ? 4 : 0) + (b4 ? 8 : 0);
    pd[i0 >> 1] = pk2(k2[0], k2[1]);
}
DI void peer_dots_d(Frame& F) {
    const unsigned char* U8 = wsp<unsigned char>(F, WS_UB); const bf16* H1B = wsp<bf16>(F, WS_H1B);
    const unsigned* PAIRS = wsp<unsigned>(F, WS_PAIRS); unsigned* PD = wsp<unsigned>(F, WS_PD); unsigned* ctl = wsp<unsigned>(F, WS_CTL);
    const int lane = F.lane, grp = lane >> 3, sub = lane & 7;
    const unsigned xcc = xb_xcc_id() & 7u;
    constexpr int NI = MR / 8;
#define PD_DEQ(q) ({ unsigned _v = 0u; if (lane == 0) _v = __hip_atomic_fetch_add((q), 1u, __ATOMIC_RELAXED, __HIP_MEMORY_SCOPE_AGENT); (int)_v; })
#define PD_LOADE(it, a0, a1) do { _Pragma("unroll") for (int _i = 0; _i < 8; ++_i) { a0[_i] = PAIRS[(size_t)((it) * 8 + _i) * 128 + lane]; a1[_i] = PAIRS[(size_t)((it) * 8 + _i) * 128 + 64 + lane]; } } while (0)
    for (int k = 0; k < P_NSL; ++k) {
        const int sl = (int)((xcc * (P_NSL / 8) + k) & (P_NSL - 1));
        unsigned* q = ctl + CW_Q + sl * 64;
        int cur = __builtin_amdgcn_readfirstlane(PD_DEQ(q));
        if (cur >= NI) continue;
        int nxt = __builtin_amdgcn_readfirstlane(PD_DEQ(q));
        unsigned e0[8], e1[8];
        PD_LOADE(cur, e0, e1);
        const unsigned char* ub = U8 + (size_t)sl * P_SLB + sub * 16;
        for (;;) {
            const int nn_raw = PD_DEQ(q);
            const bool hn = nxt < NI;
            const int m0 = cur * 8;
            const bf16* xr = (const bf16*)(wsp<unsigned char>(F, WS_XQ) + (size_t)m0 * 2048 + sl * 256 + sub * 16); const float* xsp = wsp<float>(F, WS_XSC) + (size_t)m0 * 8 + sl;
            constexpr int XSTEP = 1024  , XSS = 8;
            unsigned* pd = PD + ((size_t)m0 * P_NSL + sl) * 64 + grp * 8;
            PdUnit A, B;
            pd_issue(A, ub, xr, xsp, e0[0], e1[0], grp);
#pragma unroll
            for (int i = 0; i < 8; i += 2) {
                pd_issue(B, ub, xr + (size_t)(i + 1) * XSTEP, xsp + (i + 1) * XSS, e0[i + 1], e1[i + 1], grp);
                pd_compute(A, pd + (size_t)i * (P_NSL * 64), sub);
                if (i + 2 < 8) pd_issue(A, ub, xr + (size_t)(i + 2) * XSTEP, xsp + (i + 2) * XSS, e0[i + 2], e1[i + 2], grp);
                pd_compute(B, pd + (size_t)(i + 1) * (P_NSL * 64), sub);
            }
            if (!hn) break;
            cur = nxt; nxt = __builtin_amdgcn_readfirstlane(nn_raw);
            PD_LOADE(cur, e0, e1);
        }
    }
#undef PD_DEQ
#undef PD_LOADE
}
DI void peer_reduce(Frame& F) {
    const unsigned* PD = wsp<unsigned>(F, WS_PD); const float* R1 = wsp<float>(F, WS_R1); const unsigned* PAIRS = wsp<unsigned>(F, WS_PAIRS); unsigned* PAT = wsp<unsigned>(F, WS_PAT);
    const int lane = F.lane;
    for (int m = F.gw; m < MR; m += F.NGW) {
        const u32x2 p0 = {PAIRS[(size_t)m * 128 + lane], PAIRS[(8 * MiB) / 4 + (size_t)m * 128 + lane]}, p1 = {PAIRS[(size_t)m * 128 + 64 + lane], PAIRS[(8 * MiB) / 4 + (size_t)m * 128 + 64 + lane]};
        float s0 = 0.f, s1 = 0.f;
#pragma unroll
        for (int sl = 0; sl < P_NSL; ++sl) {
            const int h = (lane & 7) * 16 + (lane >> 3); const unsigned w0 = PD[((size_t)m * P_NSL + sl) * 64 + (h >> 1)], w1 = PD[((size_t)m * P_NSL + sl) * 64 + ((h + 8) >> 1)];
            s0 += (h & 1) ? hi_f(w0) : lo_f(w0); s1 += (h & 1) ? hi_f(w1) : lo_f(w1); }
        const float r1 = R1[m]; const f32x2* SUV = wsp<f32x2>(F, WS_SU); const f32x2 t0 = SUV[p0.x], t1 = SUV[p1.x];
        const float z0 = s0 * r1 * t0.x, z1 = s1 * r1 * t1.x;
        const float a0 = __uint_as_float(p0.y) * t0.y * 0.5f * z0 * (1.0f + erff(z0 * 0.70710678118654752f));
        const float a1 = __uint_as_float(p1.y) * t1.y * 0.5f * z1 * (1.0f + erff(z1 * 0.70710678118654752f));
        float amax = fmaxf(fabsf(a0), fabsf(a1));
#pragma unroll
        for (int o = 1; o < 64; o <<= 1) amax = fmaxf(amax, __shfl_xor(amax, o));
        unsigned ex = (__float_as_uint(amax) >> 23) & 255u; ex = ex < 40u ? 40u : (ex > 200u ? 200u : ex);
        const float s = __uint_as_float((267u - ex) << 23), sinv24 = __uint_as_float((ex + 11u) << 23);
        const _Float16 h0 = (_Float16)(a0 * s), h1 = (_Float16)(a1 * s);
        const float ssum = wave_sum((float)h0 + (float)h1);
        PAT[(size_t)m * 128 + lane] = ((unsigned)__builtin_bit_cast(unsigned short, h0) << 16) | p0.x;
        PAT[(size_t)m * 128 + 64 + lane] = ((unsigned)__builtin_bit_cast(unsigned short, h1) << 16) | p1.x;
        if (lane == 0) *(f32x2*)(wsp<float>(F, WS_TS) + (size_t)m * 2) = (f32x2){sinv24, -8.0f * ssum * sinv24 * (1.0f / 16777216.0f)};
    }
}
struct PoUnit { u32x4 w[16]; unsigned ap[8]; };
DI void po_issue(PoUnit& u, const unsigned char* vb, unsigned w0, unsigned w1, int grp) {
#pragma unroll
    for (int q = 0; q < 16; ++q) { const unsigned wd = (unsigned)__shfl((int)(q < 8 ? w0 : w1), (q & 7) * 8 + grp); u.w[q] = *(const u32x4*)(vb + (size_t)(wd & 0xffffu) * P_RB);
        if (q & 1) u.ap[q >> 1] |= (wd & 0xffff0000u); else u.ap[q >> 1] = wd >> 16; }
}
DI void po_step(PoUnit& u, unsigned l0, unsigned l1, const unsigned char* vb, int grp, float* orow, const bf16* hrow_n, const float* tsp_n, f32x2& ts, u32x2& hb, int lane) {
    const bool b32 = (lane & 32) != 0, b16 = (lane & 16) != 0, b8 = (lane & 8) != 0;
    const int col = 32 * (lane & 7) + (b32 ? 16 : 0) + (b16 ? 8 : 0) + (b8 ? 4 : 0);
    const f32x2 ts_n = *(const f32x2*)tsp_n; const u32x2 hb_n = *(const u32x2*)(hrow_n + col);
    __builtin_amdgcn_sched_barrier(0);
    h16x2 acc[16];
#pragma unroll
    for (int i = 0; i < 16; ++i) acc[i] = (h16x2){(_Float16)0.f, (_Float16)0.f};
#pragma unroll
    for (int qp = 0; qp < 8; ++qp) {
        const unsigned wa = (unsigned)__shfl((int)(qp < 4 ? l0 : l1), ((2 * qp) & 7) * 8 + grp), wb = (unsigned)__shfl((int)(qp < 4 ? l0 : l1), ((2 * qp + 1) & 7) * 8 + grp);
        __builtin_amdgcn_sched_barrier(0);
#pragma unroll
        for (int h = 0; h < 2; ++h) { const int q = 2 * qp + h;
            const h16x2 a2 = __builtin_bit_cast(h16x2, __builtin_amdgcn_perm(u.ap[qp], u.ap[qp], h ? 0x03020302u : 0x01000100u));
#pragma unroll
            for (int c = 0; c < 4; ++c) { const unsigned wd = u.w[q][c], wu = __builtin_amdgcn_perm(wd, wd, 0x0c030c01u);
                acc[4 * c] += a2 * __builtin_bit_cast(h16x2, wd & 0x000f000fu); acc[4 * c + 1] += a2 * __builtin_bit_cast(h16x2, wd & 0x00ff00ffu);
                acc[4 * c + 2] += a2 * __builtin_bit_cast(h16x2, wu & 0x000f000fu); acc[4 * c + 3] += a2 * __builtin_bit_cast(h16x2, wu); } }
        __builtin_amdgcn_sched_barrier(0);
        { u.w[2 * qp] = *(const u32x4*)(vb + (size_t)(wa & 0xffffu) * P_RB); u.w[2 * qp + 1] = *(const u32x4*)(vb + (size_t)(wb & 0xffffu) * P_RB);
          u.ap[qp] = (wa >> 16) | (wb & 0xffff0000u); }
        __builtin_amdgcn_sched_barrier(0);
    }
    h16x2 k8[8], k4[4], k2[2];
#define PO_XCH(v, m) __builtin_bit_cast(h16x2, (unsigned)__shfl_xor((int)__builtin_bit_cast(unsigned, (v)), (m)))
#pragma unroll
    for (int i = 0; i < 8; ++i) { const h16x2 snd = b32 ? acc[i] : acc[i + 8]; k8[i] = (b32 ? acc[i + 8] : acc[i]) + PO_XCH(snd, 32); }
#pragma unroll
    for (int i = 0; i < 4; ++i) { const h16x2 snd = b16 ? k8[i] : k8[i + 4]; k4[i] = (b16 ? k8[i + 4] : k8[i]) + PO_XCH(snd, 16); }
#pragma unroll
    for (int i = 0; i < 2; ++i) { const h16x2 snd = b8 ? k4[i] : k4[i + 2]; k2[i] = (b8 ? k4[i + 2] : k4[i]) + PO_XCH(snd, 8); }
#undef PO_XCH
    const float c0 = ts.x, c0b = ts.x * 0.0625f, c1 = ts.y;
    const f32x4 ov = (f32x4){lo_f(hb.x) + ((float)k2[0].x * c0 + c1), hi_f(hb.x) + ((float)k2[0].y * c0 + c1),
                             lo_f(hb.y) + (((float)k2[1].x - (float)k2[0].x) * c0b + c1), hi_f(hb.y) + (((float)k2[1].y - (float)k2[0].y) * c0b + c1)};
    __builtin_nontemporal_store(ov, (f32x4*)(orow + col));
    ts = ts_n; hb = hb_n;
}
DI void peer_out_d(Frame& F) {
    const unsigned char* V8 = wsp<unsigned char>(F, WS_VB); const bf16* H1B = wsp<bf16>(F, WS_H1B); const unsigned* PAT = wsp<unsigned>(F, WS_PAT); unsigned* ctl = wsp<unsigned>(F, WS_CTL);
    const int lane = F.lane, grp = lane >> 3, sub = lane & 7;
    const unsigned xcc = xb_xcc_id() & 7u;
    constexpr int NI = MR / 8;
#define PO_DEQ(q) ({ unsigned _v = 0u; if (lane == 0) _v = __hip_atomic_fetch_add((q), 1u, __ATOMIC_RELAXED, __HIP_MEMORY_SCOPE_AGENT); (int)_v; })
#define PO_TOK(j) ((j) < 8 ? cur * 8 + (j) : (nxt * 8 + (j) - 8 < MR ? nxt * 8 + (j) - 8 : MR - 1))
    for (int k = 0; k < P_NSL; ++k) {
        const int sl = (int)((xcc * (P_NSL / 8) + k) & (P_NSL - 1));
        unsigned* q = ctl + CW_Q + (16 + sl) * 64;
        int cur = __builtin_amdgcn_readfirstlane(PO_DEQ(q));
        if (cur >= NI) continue;
        int nxt = __builtin_amdgcn_readfirstlane(PO_DEQ(q));
        const unsigned char* vb = V8 + (size_t)sl * P_SLB + sub * 16;
        PoUnit A, B;
        unsigned la0, la1, lb0, lb1;
        { const int t0 = PO_TOK(0), t1 = PO_TOK(1), t2 = PO_TOK(2), t3 = PO_TOK(3);
          const unsigned x0 = PAT[(size_t)t0 * 128 + lane], y0 = PAT[(size_t)t0 * 128 + 64 + lane], x1 = PAT[(size_t)t1 * 128 + lane], y1 = PAT[(size_t)t1 * 128 + 64 + lane];
          la0 = PAT[(size_t)t2 * 128 + lane]; la1 = PAT[(size_t)t2 * 128 + 64 + lane]; lb0 = PAT[(size_t)t3 * 128 + lane]; lb1 = PAT[(size_t)t3 * 128 + 64 + lane];
          po_issue(A, vb, x0, y0, grp); po_issue(B, vb, x1, y1, grp); }
        f32x2 ts_c; u32x2 hb_c;
        { const int t0 = PO_TOK(0); const int col = 32 * (lane & 7) + ((lane & 32) ? 16 : 0) + ((lane & 16) ? 8 : 0) + ((lane & 8) ? 4 : 0);
          ts_c = *(const f32x2*)(wsp<float>(F, WS_TS) + (size_t)t0 * 2); hb_c = *(const u32x2*)(H1B + (size_t)t0 * D + sl * P_COLS + col); }
        for (;;) {
            const int nn_raw = PO_DEQ(q);
            const bool hn = nxt < NI;
            const int m0 = cur * 8;
            float* orow = F.out + (size_t)m0 * D + sl * P_COLS;
#pragma unroll
            for (int i = 0; i < 8; ++i) {
                const int t4 = PO_TOK(i + 4), t1 = PO_TOK(i + 1);
                const unsigned lc0 = PAT[(size_t)t4 * 128 + lane], lc1 = PAT[(size_t)t4 * 128 + 64 + lane];
                po_step((i & 1) ? B : A, la0, la1, vb, grp, orow + (size_t)i * D, H1B + (size_t)t1 * D + sl * P_COLS, wsp<float>(F, WS_TS) + (size_t)t1 * 2, ts_c, hb_c, lane);
                la0 = lb0; la1 = lb1; lb0 = lc0; lb1 = lc1;
            }
            if (!hn) break;
            cur = nxt; nxt = __builtin_amdgcn_readfirstlane(nn_raw);
        }
    }
#undef PO_DEQ
#undef PO_TOK
}
constexpr int NPHASE = 9;
__global__ void __launch_bounds__(NTHREADS, 2) mk_fwd(Args args) {
    extern __shared__ __attribute__((aligned(16))) unsigned char lds_raw[];
    Frame F;
    F.lds = (LAS unsigned char*)lds_raw;
    F.tid = threadIdx.x; F.lane = F.tid & 63; F.wave = __builtin_amdgcn_readfirstlane(F.tid >> 6);
    F.G = gridDim.x; F.gw = blockIdx.x * NWAVES + F.wave; F.NGW = F.G * NWAVES;
    F.x = args.in[0]; F.meta = args.in[1]; F.g_mix = args.in[2]; F.w_in = args.in[3]; F.conv_w = args.in[4]; F.g_q = args.in[5]; F.g_k = args.in[6]; F.g_out = args.in[7];
    F.w_out = args.in[8]; F.g_ffn = args.in[9]; F.w_query = args.in[10]; F.sub_keys = args.in[11]; F.eu = args.in[12]; F.ev = args.in[13];
    F.out = args.out; F.ws = args.ws;
    volatile LAS unsigned* MISC = (volatile LAS unsigned*)(F.lds + LDSCTL_OFF);
    for (int u = F.tid; u < (LDS_BYTES - LDSCTL_OFF) / 4; u += NTHREADS) ((LAS unsigned*)(F.lds + LDSCTL_OFF))[u] = 0u;
    __syncthreads();
    const int lo = args.ph_lo, hi = args.ph_hi;
    XcdBarrier bar; bar.bar = wsp<unsigned>(F, WS_CTL) + CW_BAR; bar.x = 0; bar.st = nullptr;
    if (hi - lo > 1) bar = xcd_barrier_post(wsp<unsigned>(F, WS_CTL) + CW_BAR, MISC + 8);
#ifndef REPEAT_MASK
#define REPEAT_MASK 0
#endif
#define IN(k) (lo <= (k) && (k) < hi)
#define REP(k) (((REPEAT_MASK) >> (k)) & 1 ? 2 : 1)
#define SEAM(k) do { if (IN(k) && IN((k) + 1)) xcd_barrier(bar); } while (0)

    const bool tab_first = (blockIdx.x & 1) == 0;
    if (IN(0)) { for (int rep = 0; rep < REP(0); ++rep) p0_prep(F); } SEAM(0);
    if (IN(1)) for (int rep = 0; rep < REP(1); ++rep) {
        p2_norm_conv<1>(F);
        __syncthreads();
        pg8::Gemm g{wsp<bf16>(F, WS_XB), wsp<bf16>(F, WS_W1T), MR, NPROJ, D / 2}; pg8::StaticOrder S; S.init(MR, NPROJ, F.G, (int)blockIdx.x);
        EpiG1 E{wsp<float>(F, WS_R0), wsp<bf16>(F, WS_GB), wsp<bf16>(F, WS_GC), wsp<bf16>(F, WS_CI), wsp<bf16>(F, WS_Q), wsp<bf16>(F, WS_K), wsp<bf16>(F, WS_VT), F.g_q, F.g_k, (LAS float*)(F.lds + LDSCTL_OFF + 1024), (const unsigned*)(F.ws + WS_CTL + CB_CM)};
        pg8::gemm_phase<EpiG1, pg8::StaticOrder, true, true, false, true>(F.lds, g, S, E);

    } SEAM(1);
#if FAST_ATTN
    if (IN(3)) {
        for (int step = 0; step < 2; ++step) {
            if ((step == 0) == (F.wave >= 4)) { for (int rep = 0; rep < REP(10); ++rep) p2_norm_conv<0>(F); }
            else for (int rep = 0; rep < REP(3); ++rep) attn_fast(F);
        }
    } SEAM(3);
#else
    if (IN(3)) { attn_simple(F); } SEAM(3);
#endif
    if (IN(4) && tab_first) { for (int rep = 0; rep < REP(11); ++rep) table_rows(F, 4); }
    if (IN(4)) for (int rep = 0; rep < REP(4); ++rep) {
        pg8::Gemm g{wsp<bf16>(F, WS_MIX), wsp<bf16>(F, WS_WOT), MR, D, D / 2}; pg8::StaticOrder S; S.init(MR, D, F.G, (int)blockIdx.x);
        EpiG2 E{wsp<unsigned char>(F, WS_XB), wsp<float>(F, WS_SX), wsp<bf16>(F, WS_H1B), wsp<float>(F, WS_SS1), wsp<unsigned char>(F, WS_H1F8), (const unsigned*)(F.ws + WS_CTL + CB_CM2)};
        pg8::gemm_phase<EpiG2, pg8::StaticOrder, true, true, false, true>(F.lds, g, S, E);
    }
    if (IN(4) && !tab_first) { for (int rep = 0; rep < REP(11); ++rep) table_rows(F, 4); }
    SEAM(4);
    if (IN(5) && tab_first) { for (int rep = 0; rep < REP(12); ++rep) table_rows(F, 2);
        for (int rep = 0; rep < REP(13); ++rep) table_rows(F, 6); }
    if (IN(5)) for (int rep = 0; rep < REP(5); ++rep) {
#if G3_FP8
        pg8::Gemm g{wsp<bf16>(F, WS_H1F8), wsp<bf16>(F, WS_W2T), MR, D, D / 2}; pg8::StaticOrder S; S.init(MR, D, F.G, (int)blockIdx.x);
        EpiG3 E{wsp<unsigned short>(F, WS_SC)};
        pg8::gemm_phase<EpiG3, pg8::StaticOrder, true, true, true>(F.lds, g, S, E);
#else
        pg8::Gemm g{wsp<bf16>(F, WS_H1B), wsp<bf16>(F, WS_W2T), MR, D, D}; pg8::StaticOrder S; S.init(MR, D, F.G, (int)blockIdx.x);
        EpiG3 E{wsp<unsigned short>(F, WS_SC)};
        pg8::gemm_phase<EpiG3, pg8::StaticOrder, true, true>(F.lds, g, S, E);
#endif
    }
    if (IN(5)) { asm volatile("s_waitcnt vmcnt(0)" ::: "memory"); __syncthreads(); }
    if (IN(6)) {
        for (int step = 0; step < 2; ++step) {
            if ((step == 0) == (F.wave >= 4)) { if (!tab_first) { for (int rep = 0; rep < REP(12); ++rep) table_rows(F, 2);
                for (int rep = 0; rep < REP(13); ++rep) table_rows(F, 6); }
            }
            else for (int rep = 0; rep < REP(6); ++rep) topk_fast<true>(F);
        }
    } SEAM(6);
    if (IN(7)) { for (int rep = 0; rep < REP(7); ++rep) { if (rep) { xcd_barrier(bar); if (blockIdx.x == 0 && F.tid < 16) __hip_atomic_store(wsp<unsigned>(F, WS_CTL) + CW_Q + F.tid * 64, 0u, __ATOMIC_RELAXED, __HIP_MEMORY_SCOPE_AGENT); xcd_barrier(bar); } peer_dots_d(F); } xcd_barrier(bar); for (int rep = 0; rep < REP(9); ++rep) peer_reduce(F); } SEAM(7);
    if (IN(8)) { for (int rep = 0; rep < REP(8); ++rep) { if (rep) { xcd_barrier(bar); if (blockIdx.x == 0 && F.tid < 16) __hip_atomic_store(wsp<unsigned>(F, WS_CTL) + CW_Q + (16 + F.tid) * 64, 0u, __ATOMIC_RELAXED, __HIP_MEMORY_SCOPE_AGENT); xcd_barrier(bar); } peer_out_d(F); } }
#undef IN
#undef SEAM
}

extern "C" void kernel_launch(void* const* d_in, const int* in_sizes, int n_in, void* d_out, int out_size, void* d_ws, size_t ws_size, hipStream_t stream) {
    static int grid = 0;
    if (grid == 0) {
        if (n_in != 14 || in_sizes[0] != MR * D || out_size != MR * D || ws_size < WS_END) {
            fprintf(stderr, "kernel_launch: unexpected shapes: n_in %d in0 %d out %d ws %zu (need %zu)\n", n_in, n_in > 0 ? in_sizes[0] : -1, out_size, ws_size, (size_t)WS_END); grid = -1; return; }
        int dev = 0, cus = 0;
        if (hipGetDevice(&dev) != hipSuccess || hipDeviceGetAttribute(&cus, hipDeviceAttributeMultiprocessorCount, dev) != hipSuccess) { grid = -1; return; }
        if (hipFuncSetAttribute((const void*)mk_fwd, hipFuncAttributeMaxDynamicSharedMemorySize, LDS_BYTES) != hipSuccess) { fprintf(stderr, "kernel_launch: hipFuncSetAttribute failed\n"); grid = -1; return; }
        (void)hipGetLastError();
        grid = cus;
    }
    if (grid < 0) return;
    (void)hipMemsetAsync((char*)d_ws + WS_CTL, 0, CTL_ZERO_BYTES, stream);
    Args a{};
    for (int i = 0; i < 14; ++i) a.in[i] = (const float*)d_in[i];
    a.out = (float*)d_out; a.ws = (unsigned char*)d_ws;
#if N_LAUNCH_PER_PHASE
    for (int p = 0; p < NPHASE; ++p) { a.ph_lo = p; a.ph_hi = p + 1; hipLaunchKernelGGL(mk_fwd, dim3(grid), dim3(NTHREADS), LDS_BYTES, stream, a); }
#else
    a.ph_lo = 0; a.ph_hi = NPHASE; hipLaunchKernelGGL(mk_fwd, dim3(grid), dim3(NTHREADS), LDS_BYTES, stream, a);
#endif
}
```
